# Optimizing an MI355X kernel written in HIP

```python
import math
import jax, jax.numpy as jnp
from jax import lax
import numpy as np

D_MODEL = 4096
BATCH = 4
SEQ = 4096
DEPTH = 2

CHUNK = 64
Q_BLOCK = 128
A_HEADS = 12
A_NOPE = 128
A_ROPE = 64
A_VDIM = 128
A_Q_LORA = 768
A_KV_LORA = 512
S_GROUP_CH = 16
S_WIDTH = 1024
S_GROUPS = S_WIDTH // S_GROUP_CH
S_STATE = 64
S_DT_MIN = 1e-3
S_DT_MAX = 1e-1
C_HEADS = 12
C_HEAD_DIM = 128
I_HEADS = 16
I_DIM = 64
I_ROPE = 32
TOPK_MAX = 256
T5_BUCKETS = 32
T5_MAX_DIST = 128
D_FF = 4 * D_MODEL
ROPE_THETA = 10000.0
LN_EPS = 1e-5
RMS_EPS = 1e-6
DEEPNORM_ALPHA = (2 * DEPTH) ** 0.25
DEEPNORM_BETA = (8 * DEPTH) ** -0.25
MIX_WIDTH = A_HEADS * A_VDIM + S_WIDTH + C_HEADS * C_HEAD_DIM
IN_SIZES = (A_Q_LORA, A_KV_LORA, A_ROPE,
            S_WIDTH,
            C_HEADS * C_HEAD_DIM, C_HEAD_DIM, C_HEAD_DIM,
            I_HEADS * I_DIM, I_DIM, I_HEADS)
IN_WIDTH = sum(IN_SIZES)

kernel_name = "hybrid_mla_s5_dsa_deepnorm_trunk"


def layer_norm(x, g, b):
    xf = x.astype(jnp.float32)
    mu = jnp.mean(xf, axis=-1, keepdims=True)
    var = jnp.mean(jnp.square(xf - mu), axis=-1, keepdims=True)
    y = (xf - mu) * lax.rsqrt(var + LN_EPS) * g.astype(jnp.float32) + b.astype(jnp.float32)
    return y.astype(x.dtype)


def rms_norm(x, g):
    xf = x.astype(jnp.float32)
    y = xf * lax.rsqrt(jnp.mean(xf * xf, axis=-1, keepdims=True) + RMS_EPS) * g.astype(jnp.float32)
    return y.astype(x.dtype)


def rope_tables(pos, dim):
    inv = ROPE_THETA ** (-jnp.arange(0, dim, 2, dtype=jnp.float32) / dim)
    ang = pos.astype(jnp.float32)[:, None] * inv[None, :]
    return jnp.cos(ang), jnp.sin(ang)


def apply_rope(x, cos, sin):
    half = x.shape[-1] // 2
    x1 = x[..., :half].astype(jnp.float32)
    x2 = x[..., half:].astype(jnp.float32)
    return jnp.concatenate([x1 * cos - x2 * sin, x2 * cos + x1 * sin], axis=-1).astype(x.dtype)


def t5_bucket(rel):
    half = T5_BUCKETS // 2
    max_exact = half // 2
    ret = jnp.where(rel > 0, half, 0)
    n = jnp.abs(rel)
    nf = jnp.maximum(n, 1).astype(jnp.float32)
    large = max_exact + (jnp.log(nf / max_exact) / math.log(T5_MAX_DIST / max_exact)
                         * (half - max_exact)).astype(jnp.int32)
    large = jnp.minimum(large, half - 1)
    return ret + jnp.where(n < max_exact, n, large)


def to_blocks(a):
    bsz, length = a.shape[:2]
    return jnp.moveaxis(a.reshape((bsz, length // Q_BLOCK, Q_BLOCK) + a.shape[2:]), 1, 0)


def from_blocks(a):
    n, bsz, qb = a.shape[:3]
    return jnp.moveaxis(a, 0, 1).reshape((bsz, n * qb) + a.shape[3:])


def mla_mixer(q_lat, kv_lat, k_rope_raw, g_q, w_uq, g_kv, w_ukv, cos, sin, chunk):
    bsz, length, _ = q_lat.shape
    q = (rms_norm(q_lat, g_q) @ w_uq).reshape(bsz, length, A_HEADS, A_NOPE + A_ROPE)
    q_nope = q[..., :A_NOPE]
    q_rope = apply_rope(q[..., A_NOPE:], cos[:, None], sin[:, None])
    kv = (rms_norm(kv_lat, g_kv) @ w_ukv).reshape(bsz, length, A_HEADS, A_NOPE + A_VDIM)
    k_nope, v = kv[..., :A_NOPE], kv[..., A_NOPE:]
    k_rope = apply_rope(k_rope_raw, cos, sin)
    scale = (A_NOPE + A_ROPE) ** -0.5

    def attend(args):
        qn, qr, cq = args
        s = jnp.einsum('bqhd,bkhd->bhqk', qn, k_nope) + jnp.einsum('bqhd,bkd->bhqk', qr, k_rope)
        s = s.astype(jnp.float32) * scale
        s = jnp.where((chunk[None, :] <= cq[:, None])[None, None], s, -jnp.inf)
        p = jax.nn.softmax(s, axis=-1).astype(v.dtype)
        return jnp.einsum('bhqk,bkhd->bqhd', p, v)

    o = lax.map(attend, (to_blocks(q_nope), to_blocks(q_rope), chunk.reshape(-1, Q_BLOCK)))
    return from_blocks(o).reshape(bsz, length, A_HEADS * A_VDIM)


def _complex_linear_combine(e1, e2):
    a1r, a1i, b1r, b1i = e1
    a2r, a2i, b2r, b2i = e2
    ar = a2r * a1r - a2i * a1i
    ai = a2r * a1i + a2i * a1r
    br = a2r * b1r - a2i * b1i + b2r
    bi = a2r * b1i + a2i * b1r + b2i
    return ar, ai, br, bi


def s5_mixer(u, lam_re, lam_im, log_step, b_re, b_im, c_re, c_im, d_skip, w_glu, b_glu):
    f32 = jnp.float32
    bsz, length, _ = u.shape
    uf = u.astype(f32).reshape(bsz, length, S_GROUPS, S_GROUP_CH)
    lr, li = lam_re.astype(f32), lam_im.astype(f32)
    dt = jnp.exp(log_step.astype(f32))[:, None]
    mag = jnp.exp(lr * dt)
    ab_re, ab_im = mag * jnp.cos(li * dt), mag * jnp.sin(li * dt)
    den = lr * lr + li * li
    nr, ni = ab_re - 1.0, ab_im
    co_re = (nr * lr + ni * li) / den
    co_im = (ni * lr - nr * li) / den
    br, bi = b_re.astype(f32), b_im.astype(f32)
    bb_re = co_re[..., None] * br - co_im[..., None] * bi
    bb_im = co_re[..., None] * bi + co_im[..., None] * br
    bu_re = jnp.einsum('blgp,gnp->blgn', uf, bb_re)
    bu_im = jnp.einsum('blgp,gnp->blgn', uf, bb_im)
    a_re = jnp.broadcast_to(ab_re, (1, length, S_GROUPS, S_STATE))
    a_im = jnp.broadcast_to(ab_im, (1, length, S_GROUPS, S_STATE))
    _, _, h_re, h_im = lax.associative_scan(_complex_linear_combine, (a_re, a_im, bu_re, bu_im), axis=1)
    y = (jnp.einsum('blgn,gpn->blgp', h_re, c_re.astype(f32))
         - jnp.einsum('blgn,gpn->blgp', h_im, c_im.astype(f32))
         + d_skip.astype(f32) * uf)
    g = jax.nn.gelu(y).reshape(bsz, length, S_WIDTH)
    out = g * jax.nn.sigmoid(g @ w_glu.astype(f32) + b_glu.astype(f32))
    return out.astype(u.dtype)


def dsa_mixer(q, k, v, q_i, k_i, w_i, rel_bias, cos, sin, pos, k_sel):
    f32 = jnp.float32
    bsz, length, _ = q.shape
    q = q.reshape(bsz, length, C_HEADS, C_HEAD_DIM)
    q_i = q_i.reshape(bsz, length, I_HEADS, I_DIM)
    q_i = jnp.concatenate([apply_rope(q_i[..., :I_ROPE], cos[:, None], sin[:, None]), q_i[..., I_ROPE:]], axis=-1)
    k_i = jnp.concatenate([apply_rope(k_i[..., :I_ROPE], cos, sin), k_i[..., I_ROPE:]], axis=-1)
    chunk = pos // CHUNK
    scale = C_HEAD_DIM ** -0.5
    idx_scale = (I_DIM * I_HEADS) ** -0.5
    gather = jax.vmap(lambda a, i: a[i])

    def attend(args):
        qb, qib, wib, tq = args
        cq = tq // CHUNK
        dots = jnp.einsum('bqhd,bkd->bqhk', qib, k_i).astype(f32)
        score = jnp.einsum('bqhk,bqh->bqk', jax.nn.relu(dots), wib.astype(f32)) * idx_scale
        admissible = chunk[None, :] <= cq[:, None]
        score = jnp.where(admissible[None], score, -jnp.inf)
        _, sel = lax.top_k(score, k_sel)
        valid = (sel // CHUNK) <= cq[None, :, None]
        kg = gather(k, sel)
        vg = gather(v, sel)
        bias = rel_bias[t5_bucket(sel - tq[None, :, None])]
        s = (jnp.einsum('bqhd,bqkd->bhqk', qb, kg).astype(f32) * scale
             + jnp.moveaxis(bias, -1, 1).astype(f32))
        s = jnp.where(valid[:, None], s, -jnp.inf)
        p = jax.nn.softmax(s, axis=-1).astype(vg.dtype)
        return jnp.einsum('bhqk,bqkd->bqhd', p, vg)

    o = lax.map(attend, (to_blocks(q), to_blocks(q_i), to_blocks(w_i), pos.reshape(-1, Q_BLOCK)))
    return from_blocks(o).reshape(bsz, length, C_HEADS * C_HEAD_DIM)


def setup_inputs(seed: int = 0) -> dict:
    key = jax.random.key(seed)
    ks = jax.random.split(key, 26)
    f32 = jnp.float32

    def nrm(k, shape, s):
        return jax.random.normal(k, shape, f32) * s

    x = nrm(ks[0], (BATCH, SEQ, D_MODEL), 1.0)
    ln_in_g = 1.0 + nrm(ks[1], (D_MODEL,), 0.01)
    ln_in_b = nrm(ks[2], (D_MODEL,), 0.01)
    rel_bias = nrm(ks[3], (T5_BUCKETS, C_HEADS), 0.2)
    w_in = nrm(ks[4], (DEPTH, D_MODEL, IN_WIDTH), D_MODEL ** -0.5)
    a_gq = 1.0 + nrm(ks[5], (DEPTH, A_Q_LORA), 0.01)
    a_wuq = nrm(ks[6], (DEPTH, A_Q_LORA, A_HEADS * (A_NOPE + A_ROPE)), A_Q_LORA ** -0.5)
    a_gkv = 1.0 + nrm(ks[7], (DEPTH, A_KV_LORA), 0.01)
    a_wukv = nrm(ks[8], (DEPTH, A_KV_LORA, A_HEADS * (A_NOPE + A_VDIM)), A_KV_LORA ** -0.5)
    s_lam_re = -0.5 + nrm(ks[9], (DEPTH, S_GROUPS, S_STATE), 0.01)
    s_lam_im = jnp.broadcast_to(math.pi * jnp.arange(S_STATE, dtype=f32), (DEPTH, S_GROUPS, S_STATE))
    s_log_step = jax.random.uniform(ks[10], (DEPTH, S_GROUPS), f32,
                                    minval=math.log(S_DT_MIN), maxval=math.log(S_DT_MAX))
    s_b_re = nrm(ks[11], (DEPTH, S_GROUPS, S_STATE, S_GROUP_CH), (2 * S_GROUP_CH) ** -0.5)
    s_b_im = nrm(ks[12], (DEPTH, S_GROUPS, S_STATE, S_GROUP_CH), (2 * S_GROUP_CH) ** -0.5)
    s_c_re = nrm(ks[13], (DEPTH, S_GROUPS, S_GROUP_CH, S_STATE), (2 * S_STATE) ** -0.5)
    s_c_im = nrm(ks[14], (DEPTH, S_GROUPS, S_GROUP_CH, S_STATE), (2 * S_STATE) ** -0.5)
    s_d = nrm(ks[15], (DEPTH, S_GROUPS, S_GROUP_CH), 1.0)
    s_w_glu = nrm(ks[16], (DEPTH, S_WIDTH, S_WIDTH), S_WIDTH ** -0.5)
    s_b_glu = nrm(ks[17], (DEPTH, S_WIDTH), 0.01)
    w_out = nrm(ks[18], (DEPTH, MIX_WIDTH, D_MODEL), MIX_WIDTH ** -0.5 * DEEPNORM_BETA)
    ln1_g = 1.0 + nrm(ks[19], (DEPTH, D_MODEL), 0.01)
    ln1_b = nrm(ks[20], (DEPTH, D_MODEL), 0.01)
    w_ff1 = nrm(ks[21], (DEPTH, D_MODEL, D_FF), D_MODEL ** -0.5)
    w_ff2 = nrm(ks[22], (DEPTH, D_FF, D_MODEL), D_FF ** -0.5 * DEEPNORM_BETA)
    ln2_g = 1.0 + nrm(ks[23], (DEPTH, D_MODEL), 0.01)
    ln2_b = nrm(ks[24], (DEPTH, D_MODEL), 0.01)
    return {"x": x, "ln_in_g": ln_in_g, "ln_in_b": ln_in_b, "rel_bias": rel_bias, "w_in": w_in,
            "a_gq": a_gq, "a_wuq": a_wuq, "a_gkv": a_gkv, "a_wukv": a_wukv,
            "s_lam_re": s_lam_re, "s_lam_im": s_lam_im, "s_log_step": s_log_step,
            "s_b_re": s_b_re, "s_b_im": s_b_im, "s_c_re": s_c_re, "s_c_im": s_c_im, "s_d": s_d,
            "s_w_glu": s_w_glu, "s_b_glu": s_b_glu, "w_out": w_out, "ln1_g": ln1_g, "ln1_b": ln1_b,
            "w_ff1": w_ff1, "w_ff2": w_ff2, "ln2_g": ln2_g, "ln2_b": ln2_b}


def reference(x, ln_in_g, ln_in_b, rel_bias, w_in, a_gq, a_wuq, a_gkv, a_wukv,
              s_lam_re, s_lam_im, s_log_step, s_b_re, s_b_im, s_c_re, s_c_im, s_d,
              s_w_glu, s_b_glu, w_out, ln1_g, ln1_b, w_ff1, w_ff2, ln2_g, ln2_b):
    bsz, length, _ = x.shape
    pos = jnp.arange(length, dtype=jnp.int32)
    chunk = pos // CHUNK
    cos_a, sin_a = rope_tables(pos, A_ROPE)
    cos_i, sin_i = rope_tables(pos, I_ROPE)
    k_sel = min(TOPK_MAX, length // 4)
    splits = np.cumsum(IN_SIZES)[:-1].tolist()

    h = layer_norm(x, ln_in_g, ln_in_b)
    for l in range(DEPTH):
        proj = h @ w_in[l]
        q_lat, kv_lat, k_rope, u_ssm, q_c, k_c, v_c, q_i, k_i, w_i = jnp.split(proj, splits, axis=-1)
        a_out = mla_mixer(q_lat, kv_lat, k_rope, a_gq[l], a_wuq[l], a_gkv[l], a_wukv[l],
                          cos_a, sin_a, chunk)
        b_out = s5_mixer(u_ssm, s_lam_re[l], s_lam_im[l], s_log_step[l], s_b_re[l], s_b_im[l],
                         s_c_re[l], s_c_im[l], s_d[l], s_w_glu[l], s_b_glu[l])
        c_out = dsa_mixer(q_c, k_c, v_c, q_i, k_i, w_i, rel_bias, cos_i, sin_i, pos, k_sel)
        mix = jnp.concatenate([a_out, b_out, c_out], axis=-1) @ w_out[l]
        h = layer_norm(DEEPNORM_ALPHA * h + mix, ln1_g[l], ln1_b[l])
        ff = jnp.square(jax.nn.relu(h @ w_ff1[l])) @ w_ff2[l]
        h = layer_norm(DEEPNORM_ALPHA * h + ff, ln2_g[l], ln2_b[l])
    return h
```

```cpp
#include <hip/hip_runtime.h>
#include <cstdio>
#include <cstdint>
#include <cmath>

#define LAS __attribute__((address_space(3)))
#define GAS __attribute__((address_space(1)))
typedef unsigned short bf16;
typedef short bf16x8 __attribute__((ext_vector_type(8)));
typedef short s16x4 __attribute__((ext_vector_type(4)));
typedef float f32x2 __attribute__((ext_vector_type(2)));
typedef float f32x4 __attribute__((ext_vector_type(4)));
typedef float f32x16 __attribute__((ext_vector_type(16)));
typedef unsigned u32x2 __attribute__((ext_vector_type(2)));
typedef unsigned u32x4 __attribute__((ext_vector_type(4)));
typedef unsigned long long u64;

constexpr int SEQ = 4096, NB = 4, M = NB * SEQ, D = 4096, DFF = 16384, DEPTH = 2;
constexpr int NPROJ = 5376;
constexpr int C_QLAT = 0, C_KVLAT = 768, C_USSM = 1280, C_QC = 2304, C_KC = 3840, C_VC = 3968, C_QI = 4096, C_KROPE = 5120, C_KI = 5184, C_WI = 5248, NPROJ_USED = 5264;
constexpr int NQA = 2304, NKV = 3072;
constexpr float ALPHA = 1.4142135623730951f;
constexpr float LOG2E = 1.4426950408889634f;
constexpr float C2_A = 0.07216878364870322f * LOG2E;
constexpr float C2_C = 0.08838834764831845f * LOG2E;
constexpr float LN_EPS = 1e-5f, RMS_EPS = 1e-6f;

constexpr size_t MiB = 1u << 20;
constexpr size_t WS_CTL = 0, CTL_BYTES = 1 * MiB;
constexpr size_t WS_COSA = 1 * MiB, WS_SINA = WS_COSA + 512 * 1024, WS_COSI = 2 * MiB, WS_SINI = WS_COSI + 256 * 1024, WS_T5 = 2 * MiB + 512 * 1024;
constexpr size_t WS_S5P = 3 * MiB, S5P_STRIDE = 1 * MiB;
constexpr size_t S5P_A = 0, S5P_A512 = 32 * 1024, S5P_D = 64 * 1024, S5P_BB = 128 * 1024  , S5P_CM = 640 * 1024  ;
constexpr size_t WS_SS = 5 * MiB;
constexpr size_t WS_E = 7 * MiB;
constexpr size_t WS_MASK = 8 * MiB;
constexpr size_t WS_W0 = 16 * MiB, W_LSTRIDE = 340 * MiB;
constexpr size_t W_IN = 0, W_UQ = 42 * MiB, W_UKV = 46 * MiB, W_GLU = 49 * MiB, W_OUT = 51 * MiB, W_1 = 83 * MiB, W_2 = 211 * MiB;
constexpr size_t WS_HB = 696 * MiB;
constexpr size_t WS_OV = 824 * MiB;
constexpr size_t WS_FFH = WS_OV;
constexpr size_t WS_PROJ = WS_OV, WS_QA = WS_OV + 168 * MiB, WS_KV = WS_OV + 240 * MiB, WS_G = WS_OV + 336 * MiB, WS_MIX = WS_OV + 368 * MiB;
constexpr size_t WS_END = WS_OV + 512 * MiB;
static_assert(WS_W0 + 2 * W_LSTRIDE <= WS_HB && WS_MIX + (size_t)M * D * 2 <= WS_END && WS_PROJ + (size_t)M * NPROJ * 2 <= WS_QA, "ws map");
constexpr int CW_TMO = 0, CW_BAR = 4096, CW_Q = 16384;

constexpr int RING_BYTES = 131072, LDSCTL_OFF = RING_BYTES, LDS_BYTES = 147456;

#define RLX_AGENT __ATOMIC_RELAXED, __HIP_MEMORY_SCOPE_AGENT
__device__ __forceinline__ unsigned f2bf(float f) { unsigned u = __builtin_bit_cast(unsigned, f); return (u + 0x7fffu + ((u >> 16) & 1u)) >> 16; }
__device__ __forceinline__ float bf2f(unsigned h) { return __builtin_bit_cast(float, h << 16); }
__device__ __forceinline__ unsigned cvtpk(float lo, float hi) { unsigned r; asm volatile("v_cvt_pk_bf16_f32 %0, %1, %2" : "=v"(r) : "v"(lo), "v"(hi)); return r; }
__device__ __forceinline__ float wave_sum(float v) {
#pragma unroll
    for (int o = 1; o < 64; o <<= 1) v += __shfl_xor(v, o);
    return v;
}
namespace pg8 {
#define PG8_LAS __attribute__((address_space(3)))
typedef unsigned short bf16_t;
typedef short bf16x8 __attribute__((ext_vector_type(8)));
typedef float f32x4 __attribute__((ext_vector_type(4)));
typedef unsigned u32x4 __attribute__((ext_vector_type(4)));
constexpr int BM = 256, BK = 64, HALF = 128, HTB = HALF * BK * 2  , STAGE_BYTES = 8 * HTB, NXCD = 8, WGM = 8;

__host__ __device__ __forceinline__ int lds_byte(int r, int c) { const int st = (r >> 4) * 2 + (c >> 5), rr = r & 15, cc = c & 31, ob = rr * 64 + cc * 2; return st * 1024 + (ob ^ (((ob >> 9) & 1) << 5)); }
__host__ __device__ __forceinline__ void stage_rc(int b, int& R, int& C) { const int st = b / 1024, sb = b % 1024, swz = sb ^ (((sb >> 9) & 1) << 5); R = (st >> 1) * 16 + swz / 64; C = (st & 1) * 32 + (swz % 64) / 2; }
__host__ __device__ __forceinline__ int perm32(int rho) { const int n = rho >> 4, i = rho & 15; return 8 * (i >> 2) + 4 * n + (i & 3); }

struct Unit { int pm, pn; };
struct Gemm { const bf16_t* A; const bf16_t* Bt; int M, N, K, lda; };

struct StaticOrder {
    int nM, nN, nwg, G, c;
    __host__ __device__ void init(int M, int N, int G_, int c_) { nM = M / BM; nN = N / BM; nwg = nM * nN; G = G_; c = c_; }
    __host__ __device__ bool next(int i, Unit& u) const {
        const long L = (long)i * G + c; if (L >= nwg) return false;
        int wgid = (int)L; { const int q = nwg / NXCD, r = nwg % NXCD, xcd = wgid % NXCD, off = wgid / NXCD; wgid = (xcd < r ? xcd * (q + 1) : r * (q + 1) + (xcd - r) * q) + off; }
        const int nig = WGM * nN, gid = wgid / nig, fm = gid * WGM, gsz = (nM - fm) < WGM ? (nM - fm) : WGM;
        u.pm = fm + ((wgid % nig) % gsz); u.pn = (wgid % nig) / gsz; return true;
    }
    __device__ __forceinline__ void a_ready(const Unit&) const {}
    __device__ __forceinline__ void done(const Unit&) const {}
};
template <class Epi, class Sched, bool ALIGN_EPI = false, bool SP2 = false>
__device__ __forceinline__ void gemm_phase(PG8_LAS unsigned char* lds, const Gemm g, const Sched& S, const Epi& E) {
    int tid_ = threadIdx.x; asm volatile("" : "+v"(tid_));
    const int tid = tid_, wid = __builtin_amdgcn_readfirstlane(tid >> 6), lane = tid & 63, wr = wid >> 2, wc = wid & 3, fr = lane & 15, fq = lane >> 4;
    const int K = g.K, nt = K / BK;
    unsigned voffA[2], voffB[2];
#pragma unroll
    for (int i = 0; i < 2; ++i) { int R, C; stage_rc(tid * 16 + i * 8192, R, C); const int Rb = Epi::PERM ? ((R & ~31) + perm32(R & 31)) : R;
        voffA[i] = (unsigned)(R * g.lda + C) * 2u; voffB[i] = (unsigned)(Rb * K + C) * 2u; }
    const size_t kstep = (size_t)(BK * 2);
    const size_t hstepA = (size_t)HALF * g.lda * 2, hstepB = (size_t)HALF * K * 2;
    const size_t tstepA = 2 * hstepA, tstepB = 2 * hstepB;
    const unsigned ldsw = (unsigned)wid * 1024u;
    const int aoff = lds_byte(wr * 64 + fr, fq * 8), boff = lds_byte(wc * 32 + fr, fq * 8);
#define PG8_SA(b, h) (((b) * 2 + (h)) * HTB)
#define PG8_SB(b, h) ((4 + (b) * 2 + (h)) * HTB)
#define PG8_STAGE(bufoff, gbase, voff) do { _Pragma("unroll") for (int _i = 0; _i < 2; ++_i) \
        __builtin_amdgcn_global_load_lds((const unsigned*)((const char*)(gbase) + (voff)[_i]), (PG8_LAS unsigned*)(lds + (bufoff) + ldsw + _i * 8192), 16, 0, 0); } while (0)
#define PG8_LDA(dst, b, h) do { _Pragma("unroll") for (int m = 0; m < 4; ++m) _Pragma("unroll") for (int k = 0; k < 2; ++k) dst[m][k] = *(const PG8_LAS bf16x8*)(lds + PG8_SA(b, h) + aoff + m * 2048 + k * 1024); } while (0)
#define PG8_LDB(dst, b, h) do { _Pragma("unroll") for (int n = 0; n < 2; ++n) _Pragma("unroll") for (int k = 0; k < 2; ++k) dst[n][k] = *(const PG8_LAS bf16x8*)(lds + PG8_SB(b, h) + boff + n * 2048 + k * 1024); } while (0)
#define PG8_MMA(ai, bj, At, Bt) do { __builtin_amdgcn_s_setprio(1); _Pragma("unroll") for (int m = 0; m < 4; ++m) _Pragma("unroll") for (int n = 0; n < 2; ++n) _Pragma("unroll") for (int k = 0; k < 2; ++k) \
        acc[ai][bj][m][n] = __builtin_amdgcn_mfma_f32_16x16x32_bf16(Bt[n][k], At[m][k], acc[ai][bj][m][n], 0, 0, 0); __builtin_amdgcn_s_setprio(0); } while (0)
#define PG8_WAIT_V(n) asm volatile("s_waitcnt vmcnt(" #n ")" ::: "memory")
#define PG8_WAIT_L(n) asm volatile("s_waitcnt lgkmcnt(" #n ")" ::: "memory")
#define PG8_BAR __builtin_amdgcn_s_barrier()
#define PG8_SCHED __builtin_amdgcn_sched_barrier(0)
    Unit cur, nxt; int ui = 0;
    if (!S.next(0, cur)) return;
    f32x4 acc[2][2][4][2];
#pragma unroll
    for (int a = 0; a < 2; ++a)
#pragma unroll
        for (int b = 0; b < 2; ++b)
#pragma unroll
            for (int m = 0; m < 4; ++m)
#pragma unroll
                for (int n = 0; n < 2; ++n) acc[a][b][m][n] = (f32x4){0.f, 0.f, 0.f, 0.f};
    bf16x8 At[4][2], B0[2][2], B1[2][2];
    const char* cA = (const char*)g.A + (size_t)cur.pm * tstepA; const char* cB = (const char*)g.Bt + (size_t)cur.pn * tstepB;
    S.a_ready(cur);
    if constexpr (SP2) {
        PG8_STAGE(PG8_SB(0, 0), cB, voffB); PG8_STAGE(PG8_SB(0, 1), cB + hstepB, voffB); PG8_STAGE(PG8_SA(0, 0), cA, voffA); PG8_STAGE(PG8_SA(0, 1), cA + hstepA, voffA);
        if (wr == 1) PG8_BAR;
        PG8_WAIT_V(2); PG8_BAR;
        PG8_STAGE(PG8_SB(1, 0), cB + kstep, voffB); PG8_STAGE(PG8_SA(1, 0), cA + kstep, voffA); PG8_STAGE(PG8_SB(1, 1), cB + hstepB + kstep, voffB);
        PG8_WAIT_V(6); PG8_BAR;
    } else {
        PG8_STAGE(PG8_SB(0, 0), cB, voffB); PG8_STAGE(PG8_SA(0, 0), cA, voffA); PG8_STAGE(PG8_SB(0, 1), cB + hstepB, voffB); PG8_STAGE(PG8_SA(0, 1), cA + hstepA, voffA);
        if (wr == 1) PG8_BAR;
        PG8_WAIT_V(4); PG8_BAR;
        PG8_STAGE(PG8_SB(1, 0), cB + kstep, voffB); PG8_STAGE(PG8_SA(1, 0), cA + kstep, voffA); PG8_STAGE(PG8_SB(1, 1), cB + hstepB + kstep, voffB);
        PG8_WAIT_V(6); PG8_BAR;
    }
    for (;;) {
        const bool has_next = S.next(ui + 1, nxt);
        const char* nA = has_next ? (const char*)g.A + (size_t)nxt.pm * tstepA : cA; const char* nB = has_next ? (const char*)g.Bt + (size_t)nxt.pn * tstepB : cB;
        for (int t = 0; t < nt; t += 2) {
            const bool last = (t == nt - 2);
            const char* a1 = cA + (size_t)(t + 1) * kstep;
            const char* a2 = last ? nA : cA + (size_t)(t + 2) * kstep; const char* b2 = last ? nB : cB + (size_t)(t + 2) * kstep;
            const char* a3 = a2 + kstep; const char* b3 = b2 + kstep;
            if (last && has_next) S.a_ready(nxt);
            if constexpr (SP2) {
            PG8_LDB(B0, 0, 0); PG8_LDB(B1, 0, 1); PG8_SCHED; PG8_LDA(At, 0, 0); PG8_STAGE(PG8_SA(1, 1), a1 + hstepA, voffA);
            PG8_WAIT_V(8); PG8_WAIT_L(0); PG8_BAR; PG8_MMA(0, 0, At, B0); PG8_MMA(0, 1, At, B1); PG8_BAR; PG8_SCHED;
            PG8_LDA(At, 0, 1); PG8_STAGE(PG8_SB(0, 0), b2, voffB); PG8_STAGE(PG8_SB(0, 1), b2 + hstepB, voffB); PG8_STAGE(PG8_SA(0, 0), a2, voffA);
            PG8_WAIT_V(8); PG8_WAIT_L(0); PG8_BAR; PG8_MMA(1, 0, At, B0); PG8_MMA(1, 1, At, B1); PG8_BAR; PG8_SCHED;
            PG8_LDB(B0, 1, 0); PG8_LDB(B1, 1, 1); PG8_SCHED; PG8_LDA(At, 1, 0); PG8_STAGE(PG8_SA(0, 1), a2 + hstepA, voffA);
            PG8_WAIT_V(8); PG8_WAIT_L(0); PG8_BAR; PG8_MMA(0, 0, At, B0); PG8_MMA(0, 1, At, B1); PG8_BAR; PG8_SCHED;
            PG8_LDA(At, 1, 1); PG8_STAGE(PG8_SB(1, 0), b3, voffB); PG8_STAGE(PG8_SB(1, 1), b3 + hstepB, voffB); PG8_STAGE(PG8_SA(1, 0), a3, voffA);
            PG8_WAIT_V(8); PG8_WAIT_L(0); PG8_BAR; PG8_MMA(1, 0, At, B0); PG8_MMA(1, 1, At, B1); PG8_BAR; PG8_SCHED;
            } else {
            PG8_LDB(B0, 0, 0); PG8_SCHED; PG8_LDA(At, 0, 0); PG8_STAGE(PG8_SA(1, 1), a1 + hstepA, voffA);
            PG8_WAIT_L(8); PG8_BAR; PG8_WAIT_L(0); PG8_MMA(0, 0, At, B0); PG8_BAR; PG8_SCHED;
            PG8_LDB(B1, 0, 1); PG8_STAGE(PG8_SB(0, 0), b2, voffB);
            PG8_BAR; PG8_WAIT_L(0); PG8_MMA(0, 1, At, B1); PG8_BAR;
            PG8_LDA(At, 0, 1); PG8_STAGE(PG8_SA(0, 0), a2, voffA);
            PG8_BAR; PG8_WAIT_L(0); PG8_MMA(1, 0, At, B0); PG8_BAR; PG8_SCHED;
            PG8_STAGE(PG8_SB(0, 1), b2 + hstepB, voffB);
            PG8_WAIT_V(6); PG8_BAR; PG8_MMA(1, 1, At, B1); PG8_BAR;
            PG8_LDB(B0, 1, 0); PG8_SCHED; PG8_LDA(At, 1, 0); PG8_STAGE(PG8_SA(0, 1), a2 + hstepA, voffA);
            PG8_WAIT_L(8); PG8_BAR; PG8_WAIT_L(0); PG8_MMA(0, 0, At, B0); PG8_BAR; PG8_SCHED;
            PG8_LDB(B1, 1, 1); PG8_STAGE(PG8_SB(1, 0), b3, voffB);
            PG8_BAR; PG8_WAIT_L(0); PG8_MMA(0, 1, At, B1); PG8_BAR;
            PG8_LDA(At, 1, 1); PG8_STAGE(PG8_SA(1, 0), a3, voffA);
            PG8_BAR; PG8_WAIT_L(0); PG8_MMA(1, 0, At, B0); PG8_BAR; PG8_SCHED;
            PG8_STAGE(PG8_SB(1, 1), b3 + hstepB, voffB);
            PG8_WAIT_V(6); PG8_BAR; PG8_MMA(1, 1, At, B1); PG8_BAR;
            }
        }
        if constexpr (ALIGN_EPI) { if (wr == 0) PG8_BAR; }
        if constexpr (!Epi::AFTER_DRAIN) { E(acc, cur, wr, wc, fr, fq); S.done(cur); }
        if (!has_next) break;
#pragma unroll
        for (int a = 0; a < 2; ++a)
#pragma unroll
            for (int b = 0; b < 2; ++b)
#pragma unroll
                for (int m = 0; m < 4; ++m)
#pragma unroll
                    for (int n = 0; n < 2; ++n) acc[a][b][m][n] = (f32x4){0.f, 0.f, 0.f, 0.f};
        cur = nxt; cA = nA; cB = nB; ++ui;
        if constexpr (ALIGN_EPI) { if (wr == 1) PG8_BAR; }
    }
    PG8_WAIT_V(0);
    if constexpr (!ALIGN_EPI) { if (wr == 0) PG8_BAR; }
    PG8_BAR;
    if constexpr (Epi::AFTER_DRAIN) { E.fused(acc, cur, wr, wc, fr, fq, lds, wid, lane); S.done(cur); }
#undef PG8_SA
#undef PG8_SB
#undef PG8_STAGE
#undef PG8_LDA
#undef PG8_LDB
#undef PG8_MMA
#undef PG8_WAIT_V
#undef PG8_WAIT_L
#undef PG8_BAR
#undef PG8_SCHED
}
}
namespace pg8 {
struct EpiProj {
    static constexpr bool PERM = true, AFTER_DRAIN = false;
    bf16_t* O; float* ss; const float* cosA; const float* sinA; const float* cosI; const float* sinI;
    __device__ __forceinline__ void operator()(const f32x4 (&acc)[2][2][4][2], const Unit& u, int wr, int wc, int fr, int fq) const {
        const int row0 = u.pm * BM + wr * 64 + fr, pn = u.pn, col0 = pn * BM + wc * 32 + 8 * fq;
        int mode[2], f0[2];
#pragma unroll
        for (int bj = 0; bj < 2; ++bj) {
            int md = 0, f = 0;
            if (pn >= 9 && pn <= 14) md = 1;
            else if (pn >= 16 && pn <= 19) { if ((wc & 1) == 0) { md = 3; f = 4 * fq; } }
            else if (pn == 20 && bj == 0) { if (wc < 2) { md = 2; f = 16 * wc + 4 * fq; } else if (wc == 2) { md = 3; f = 4 * fq; } }
            mode[bj] = md; f0[bj] = f;
        }
#pragma unroll
        for (int ai = 0; ai < 2; ++ai)
#pragma unroll
            for (int m = 0; m < 4; ++m) {
                const int row = row0 + ai * HALF + m * 16, t = row & (SEQ - 1);
                bf16_t* rowp = O + (size_t)row * NPROJ + col0; float sq = 0.f;
#pragma unroll
                for (int bj = 0; bj < 2; ++bj) {
                    f32x4 v0 = acc[ai][bj][m][0], v1 = acc[ai][bj][m][1];
                    if (mode[bj] == 1) { v0 = v0 * C2_C; v1 = v1 * C2_C; }
                    else if (mode[bj] >= 2) {
                        const float* ct = mode[bj] == 2 ? cosA + t * 32 : cosI + t * 16; const float* st = mode[bj] == 2 ? sinA + t * 32 : sinI + t * 16;
                        const f32x4 c = *(const f32x4*)(ct + f0[bj]), s = *(const f32x4*)(st + f0[bj]);
                        const f32x4 o0 = v0 * c - v1 * s, o1 = v1 * c + v0 * s; v0 = o0; v1 = o1;
                    }
                    u32x4 w; w.x = cvtpk(v0[0], v0[1]); w.y = cvtpk(v0[2], v0[3]); w.z = cvtpk(v1[0], v1[1]); w.w = cvtpk(v1[2], v1[3]);
                    *(u32x4*)(rowp + bj * HALF) = w;
                    if (pn < 5) {
#pragma unroll
                        for (int e = 0; e < 4; ++e) { const float lo = bf2f(w[e] & 0xffffu), hi = bf2f(w[e] >> 16); sq += lo * lo + hi * hi; }
                    }
                }
                if (pn < 5) { sq += __shfl_xor(sq, 16); sq += __shfl_xor(sq, 32); if (fq == 0) ss[(size_t)(pn * 4 + wc) * M + row] = sq; }
            }
    }
};
template <bool QUP> struct EpiUp {
    static constexpr bool PERM = true, AFTER_DRAIN = false;
    bf16_t* O; const float* ss; const float* cosA; const float* sinA;
    __device__ __forceinline__ void operator()(const f32x4 (&acc)[2][2][4][2], const Unit& u, int wr, int wc, int fr, int fq) const {
        constexpr int ldc = QUP ? NQA : NKV, s0 = QUP ? 0 : 12, ns = QUP ? 12 : 8; constexpr float inv = QUP ? 1.f / 768.f : 1.f / 512.f, sc = QUP ? C2_A : 1.f;
        const int row0 = u.pm * BM + wr * 64 + fr, col0 = u.pn * BM + wc * 32 + 8 * fq;
        const bool rope = QUP && u.pn >= 6; const int f0 = 16 * (wc & 1) + 4 * fq;
#pragma unroll
        for (int ai = 0; ai < 2; ++ai)
#pragma unroll
            for (int m = 0; m < 4; ++m) {
                const int row = row0 + ai * HALF + m * 16, t = row & (SEQ - 1);
                float s = 0.f;
#pragma unroll
                for (int k = 0; k < ns; ++k) s += ss[(size_t)(s0 + k) * M + row];
                const float rs = sc / sqrtf(s * inv + RMS_EPS);
                bf16_t* rowp = O + (size_t)row * ldc + col0;
#pragma unroll
                for (int bj = 0; bj < 2; ++bj) {
                    f32x4 v0 = acc[ai][bj][m][0] * rs, v1 = acc[ai][bj][m][1] * rs;
                    if (rope) { const f32x4 c = *(const f32x4*)(cosA + t * 32 + f0), sn = *(const f32x4*)(sinA + t * 32 + f0);
                        const f32x4 o0 = v0 * c - v1 * sn, o1 = v1 * c + v0 * sn; v0 = o0; v1 = o1; }
                    u32x4 w; w.x = cvtpk(v0[0], v0[1]); w.y = cvtpk(v0[2], v0[3]); w.z = cvtpk(v1[0], v1[1]); w.w = cvtpk(v1[2], v1[3]);
                    *(u32x4*)(rowp + bj * HALF) = w;
                }
            }
    }
};
struct EpiGlu {
    static constexpr bool PERM = true, AFTER_DRAIN = false;
    bf16_t* O; const bf16_t* G; const float* bias;
    __device__ __forceinline__ void operator()(const f32x4 (&acc)[2][2][4][2], const Unit& u, int wr, int wc, int fr, int fq) const {
        const int row0 = u.pm * BM + wr * 64 + fr, col0 = u.pn * BM + wc * 32 + 8 * fq;
        f32x4 bv[2][2];
#pragma unroll
        for (int bj = 0; bj < 2; ++bj)
#pragma unroll
            for (int n = 0; n < 2; ++n) bv[bj][n] = *(const f32x4*)(bias + col0 + bj * HALF + 4 * n);
#pragma unroll
        for (int ai = 0; ai < 2; ++ai)
#pragma unroll
            for (int m = 0; m < 4; ++m) {
                const int row = row0 + ai * HALF + m * 16;
#pragma unroll
                for (int bj = 0; bj < 2; ++bj) {
                    const u32x4 gw = *(const u32x4*)(G + (size_t)row * 1024 + col0 + bj * HALF);
                    float o[8];
#pragma unroll
                    for (int e = 0; e < 8; ++e) { const float z = acc[ai][bj][m][e >> 2][e & 3] + bv[bj][e >> 2][e & 3];
                        const float gg = (e & 1) ? bf2f(gw[e >> 1] >> 16) : bf2f(gw[e >> 1] & 0xffffu);
                        o[e] = gg / (1.f + __expf(-z)); }
                    u32x4 w; w.x = cvtpk(o[0], o[1]); w.y = cvtpk(o[2], o[3]); w.z = cvtpk(o[4], o[5]); w.w = cvtpk(o[6], o[7]);
                    *(u32x4*)(O + (size_t)row * D + 1536 + col0 + bj * HALF) = w;
                }
            }
    }
};
struct EpiRes {
    static constexpr bool PERM = false, AFTER_DRAIN = false;
    float* X;
    __device__ __forceinline__ void operator()(const f32x4 (&acc)[2][2][4][2], const Unit& u, int wr, int wc, int fr, int fq) const {
        const int row0 = u.pm * BM + wr * 64 + fr, col0 = u.pn * BM + wc * 32 + 4 * fq;
#pragma unroll
        for (int ai = 0; ai < 2; ++ai)
#pragma unroll
            for (int m = 0; m < 4; ++m) { float* rowp = X + (size_t)(row0 + ai * HALF + m * 16) * D + col0;
                f32x4 xv[2][2];
#pragma unroll
                for (int bj = 0; bj < 2; ++bj)
#pragma unroll
                    for (int n = 0; n < 2; ++n) xv[bj][n] = *(const f32x4*)(rowp + bj * HALF + n * 16);
#pragma unroll
                for (int bj = 0; bj < 2; ++bj)
#pragma unroll
                    for (int n = 0; n < 2; ++n) *(f32x4*)(rowp + bj * HALF + n * 16) = xv[bj][n] * ALPHA + acc[ai][bj][m][n]; }
    }
};
struct EpiRelu2 {
    static constexpr bool PERM = true, AFTER_DRAIN = false;
    bf16_t* O;
    __device__ __forceinline__ void operator()(const f32x4 (&acc)[2][2][4][2], const Unit& u, int wr, int wc, int fr, int fq) const {
        const int row0 = u.pm * BM + wr * 64 + fr, col0 = u.pn * BM + wc * 32 + 8 * fq;
#pragma unroll
        for (int ai = 0; ai < 2; ++ai)
#pragma unroll
            for (int m = 0; m < 4; ++m) { bf16_t* rowp = O + (size_t)(row0 + ai * HALF + m * 16) * DFF + col0;
#pragma unroll
                for (int bj = 0; bj < 2; ++bj) { f32x4 v0 = acc[ai][bj][m][0], v1 = acc[ai][bj][m][1];
#pragma unroll
                    for (int e = 0; e < 4; ++e) { const float a = fmaxf(v0[e], 0.f), b = fmaxf(v1[e], 0.f); v0[e] = a * a; v1[e] = b * b; }
                    u32x4 w; w.x = cvtpk(v0[0], v0[1]); w.y = cvtpk(v0[2], v0[3]); w.z = cvtpk(v1[0], v1[1]); w.w = cvtpk(v1[2], v1[3]);
                    *(u32x4*)(rowp + bj * HALF) = w; } }
    }
};
}
#define XB_TMO      128
#define XB_XCNT(j)  (256  + 64 * (j))
#define XB_XSUB(j)  (1280 + 64 * (j))
#define XB_XGEN(j)  (2304 + 64 * (j))
#define XB_TOP      3328
#define XB_TOPGEN   3392
#define XCD_BAR_WORDS 3456
#define XB_SPIN_CAP (1u << 18)

__device__ __forceinline__ unsigned xb_ld(unsigned* p)              { return __hip_atomic_load(p, __ATOMIC_RELAXED, __HIP_MEMORY_SCOPE_AGENT); }
__device__ __forceinline__ unsigned xb_add(unsigned* p, unsigned v) { return __hip_atomic_fetch_add(p, v, __ATOMIC_RELAXED, __HIP_MEMORY_SCOPE_AGENT); }
__device__ __forceinline__ unsigned xb_xcc_id() { return (unsigned)__builtin_amdgcn_s_getreg((3 << 11) | 20) & 0xFu; }
#define XB_SPIN(cond, bar) do { unsigned _sp = 0; while (cond) { __builtin_amdgcn_s_sleep(1); \
    if ((++_sp & 255u) == 0u) { if (xb_ld(&(bar)[XB_TMO])) break; if (_sp > XB_SPIN_CAP) { atomicAdd(&(bar)[XB_TMO], 1u); break; } } } } while (0)

struct XcdBarrier {
    unsigned* bar; unsigned x;
    volatile LAS unsigned* st;
};

__device__ __forceinline__ XcdBarrier xcd_barrier_post(unsigned* bar, volatile LAS unsigned* st) {
    XcdBarrier b; b.bar = bar; b.x = xb_xcc_id(); b.st = st;
    if (threadIdx.x == 0) (void)xb_add(&bar[XB_XCNT(b.x)], 1u);
    return b;
}
__device__ __forceinline__ void xcd_barrier_complete(unsigned* bar, unsigned x, unsigned& nloc, unsigned& nx) {
    const unsigned G = gridDim.x * gridDim.y * gridDim.z;
    unsigned sum, cnt, mine, sp = 0u;
    for (;;) {
        sum = 0u; cnt = 0u; mine = 0u;
#pragma unroll
        for (unsigned j = 0; j < 16; ++j) { const unsigned c = xb_ld(&bar[XB_XCNT(j)]); sum += c; cnt += (c > 0u) ? 1u : 0u; mine = (j == x) ? c : mine; }
        if (sum == G) break;
        __builtin_amdgcn_s_sleep(1);
        if ((++sp & 255u) == 0u) { if (xb_ld(&bar[XB_TMO])) break; if (sp > XB_SPIN_CAP) { atomicAdd(&bar[XB_TMO], 1u); break; } }
    }
    nloc = mine > 0u ? mine : 1u; nx = cnt > 0u ? cnt : 1u;
}

__device__ __forceinline__ void xcd_barrier(const XcdBarrier& b) {
    asm volatile("s_waitcnt vmcnt(0)" ::: "memory");
    __syncthreads();
    if (threadIdx.x == 0) {
        unsigned* bar = b.bar;
        __builtin_amdgcn_s_waitcnt(0);
        unsigned nloc = b.st[0], nx = b.st[1];
        if (nloc == 0u) { xcd_barrier_complete(bar, b.x, nloc, nx); b.st[0] = nloc; b.st[1] = nx; }
        const unsigned old = xb_add(&bar[XB_XSUB(b.x)], 1u);
        const unsigned gen = old / nloc;
        if (old + 1u == (gen + 1u) * nloc) {
            __builtin_amdgcn_fence(__ATOMIC_RELEASE, "agent");
            asm volatile("s_waitcnt vmcnt(0)" ::: "memory");
            const unsigned og = xb_add(&bar[XB_TOP], 1u);
            const unsigned tg = og / nx;
            if (og + 1u == (tg + 1u) * nx) xb_add(&bar[XB_TOPGEN], 1u);
            else XB_SPIN(xb_ld(&bar[XB_TOPGEN]) == tg, bar);
            __builtin_amdgcn_fence(__ATOMIC_ACQUIRE, "agent");
            xb_add(&bar[XB_XGEN(b.x)], 1u);
            asm volatile("s_waitcnt vmcnt(0)" ::: "memory");
        } else {
            XB_SPIN(xb_ld(&bar[XB_XGEN(b.x)]) == gen, bar);
            __builtin_amdgcn_fence(__ATOMIC_ACQUIRE, "agent");
            asm volatile("s_waitcnt vmcnt(0)" ::: "memory");
        }
    }
    __syncthreads();
}

struct Frame {
    LAS unsigned char* lds;
    int tid, lane, wave, vcu, G;
};
#define CAS __attribute__((address_space(4)))
__device__ __forceinline__ const CAS char* karg_base() { const CAS char* p = (const CAS char*)__builtin_amdgcn_kernarg_segment_ptr(); asm volatile("" : "+s"(p)); return p; }
__device__ __forceinline__ const float* inp(int i) { return *(const float* const CAS*)(karg_base() + 8 * i); }
__device__ __forceinline__ float* x_base() { return *(float* const CAS*)(karg_base() + 208); }
__device__ __forceinline__ unsigned char* ws_base() { return *(unsigned char* const CAS*)(karg_base() + 216); }
__device__ __forceinline__ unsigned* ctl_base() { return (unsigned*)(ws_base() + WS_CTL); }
enum { I_X = 0, I_LNG, I_LNB, I_RELB, I_WIN, I_AGQ, I_AWUQ, I_AGKV, I_AWUKV, I_LRE, I_LIM, I_LSTEP, I_BRE, I_BIM, I_CRE, I_CIM, I_SD, I_WGLU, I_BGLU, I_WOUT, I_LN1G, I_LN1B, I_WFF1, I_WFF2, I_LN2G, I_LN2B };

__device__ __forceinline__ void dsincos(double x, double& s, double& c) {
    const double kq = rint(x * 0.6366197723675814);
    double r = fma(-kq, 1.5707963267948966, x); r = fma(-kq, 6.123233995736766e-17, r);
    const int q = (int)((long long)kq & 3);
    const double r2 = r * r;
    const double sp = r * (1.0 + r2 * (-1.0 / 6.0 + r2 * (1.0 / 120.0 + r2 * (-1.0 / 5040.0 + r2 * (1.0 / 362880.0 + r2 * (-1.0 / 39916800.0 + r2 * (1.0 / 6227020800.0 + r2 * (-1.0 / 1307674368000.0))))))));
    const double cp = 1.0 + r2 * (-0.5 + r2 * (1.0 / 24.0 + r2 * (-1.0 / 720.0 + r2 * (1.0 / 40320.0 + r2 * (-1.0 / 3628800.0 + r2 * (1.0 / 479001600.0 + r2 * (-1.0 / 87178291200.0 + r2 * (1.0 / 20922789888000.0))))))));
    s = (q == 0) ? sp : (q == 1) ? cp : (q == 2) ? -sp : -cp;
    c = (q == 0) ? cp : (q == 1) ? -sp : (q == 2) ? -cp : sp;
}
__device__ __forceinline__ void s5_coef(const Frame& F, int l, int g, int n, double& ar, double& ai, double& cr, double& ci) {
    const double lr = (double)inp(I_LRE)[(l * 64 + g) * 64 + n], li = (double)inp(I_LIM)[(l * 64 + g) * 64 + n];
    const double dt = exp((double)inp(I_LSTEP)[l * 64 + g]);
    const double mag = exp(lr * dt); double s, c; dsincos(fabs(li * dt), s, c); if (li * dt < 0.0) s = -s;
    ar = mag * c; ai = mag * s;
    const double den = lr * lr + li * li, nr = ar - 1.0, ni = ai;
    cr = (nr * lr + ni * li) / den; ci = (ni * lr - nr * li) / den;
}
__device__ __forceinline__ int il32(int d) { return d < 16 ? 8 * (d >> 2) + (d & 3) : 8 * ((d - 16) >> 2) + 4 + (d & 3); }
__device__ __forceinline__ int il64(int d) { return d < 32 ? 8 * (d >> 2) + (d & 3) : 8 * ((d - 32) >> 2) + 4 + (d & 3); }
__device__ __forceinline__ int phys_win(int n) {
    if (n < 1280) return n;
    if (n < 1344) return C_KROPE + il64(n - 1280);
    if (n < 2368) return C_USSM + (n - 1344);
    if (n < 3904) return C_QC + (n - 2368);
    if (n < 4160) return C_KC + (n - 3904);
    if (n < 5184) { const int j = n - 4160, d = j & 63; return C_QI + (j & ~63) + (d < 32 ? il32(d) : d); }
    if (n < 5248) { const int d = n - 5184; return C_KI + (d < 32 ? il32(d) : d); }
    return C_WI + (n - 5248);
}
__device__ __forceinline__ int phys_uq(int n) { const int h = n / 192, o = n - h * 192; return o < 128 ? h * 128 + o : 1536 + h * 64 + il64(o - 128); }
template <int PM  >
__device__ __forceinline__ void cvt_item(const float* W, int K, int N, bf16* WT, const float* gk, LAS float* scr, int item, int lane) {
    const int nblk = (N + 31) / 32, kb = item / nblk, nb = item - kb * nblk, k0 = 64 * kb, n0 = 32 * nb;
    const int rr = lane >> 3, n4 = (lane & 7) * 4;
#pragma unroll
    for (int i = 0; i < 8; ++i) { const int row = i * 8 + rr;
        f32x4 v = (f32x4){0.f, 0.f, 0.f, 0.f}; if (n0 + n4 < N) v = *(const f32x4*)(W + (size_t)(k0 + row) * N + n0 + n4);
        LAS float* d = scr + row * 33 + n4; d[0] = v.x; d[1] = v.y; d[2] = v.z; d[3] = v.w; }
    asm volatile("s_waitcnt lgkmcnt(0)" ::: "memory");
    const int c = lane & 7;
    float gs[8];
#pragma unroll
    for (int j = 0; j < 8; ++j) gs[j] = gk ? gk[k0 + 8 * c + j] : 1.f;
#pragma unroll
    for (int j = 0; j < 4; ++j) { const int n = (lane >> 3) + 8 * j; const LAS float* s = scr + (8 * c) * 33 + n;
        if (n0 + n < N) { const int pr = PM == 1 ? phys_win(n0 + n) : PM == 2 ? phys_uq(n0 + n) : n0 + n;
            u32x4 o; o.x = f2bf(s[0] * gs[0]) | (f2bf(s[33] * gs[1]) << 16); o.y = f2bf(s[66] * gs[2]) | (f2bf(s[99] * gs[3]) << 16);
            o.z = f2bf(s[132] * gs[4]) | (f2bf(s[165] * gs[5]) << 16); o.w = f2bf(s[198] * gs[6]) | (f2bf(s[231] * gs[7]) << 16);
            *(u32x4*)(WT + (size_t)pr * K + k0 + 8 * c) = o; } }
    asm volatile("s_waitcnt lgkmcnt(0)" ::: "memory");
}
__device__ __forceinline__ void ln_row(const float* xrow, const float* g, const float* b, float* orow, bf16* hrow, int lane) {
    f32x4 v[16]; float s = 0.f;
#pragma unroll
    for (int j = 0; j < 16; ++j) { v[j] = *(const f32x4*)(xrow + 4 * lane + 256 * j); s += (v[j].x + v[j].y) + (v[j].z + v[j].w); }
    const float mean = wave_sum(s) * (1.f / D); float s2 = 0.f;
#pragma unroll
    for (int j = 0; j < 16; ++j) { v[j] = v[j] - mean; s2 += (v[j].x * v[j].x + v[j].y * v[j].y) + (v[j].z * v[j].z + v[j].w * v[j].w); }
    const float rstd = 1.f / sqrtf(wave_sum(s2) * (1.f / D) + LN_EPS);
#pragma unroll
    for (int j = 0; j < 16; ++j) { const f32x4 gg = *(const f32x4*)(g + 4 * lane + 256 * j), bb = *(const f32x4*)(b + 4 * lane + 256 * j);
        const f32x4 y = v[j] * rstd * gg + bb; *(f32x4*)(orow + 4 * lane + 256 * j) = y;
        u32x2 w; w.x = cvtpk(y.x, y.y); w.y = cvtpk(y.z, y.w); *(u32x2*)(hrow + 4 * lane + 256 * j) = w; }
}
__device__ __forceinline__ void ln_phase(Frame& F, const float* src, const float* g, const float* b) {
    const int gw = F.vcu * 8 + F.wave, NGW = F.G * 8; bf16* HB = (bf16*)(ws_base() + WS_HB);
    for (int m = gw; m < M; m += NGW) ln_row(src + (size_t)m * D, g, b, x_base() + (size_t)m * D, HB + (size_t)m * D, F.lane);
}
__device__ __forceinline__ void p0_prologue(Frame& F) {
    const int gw = F.vcu * 8 + F.wave, NGW = F.G * 8, gt = gw * 64 + F.lane, NGT = NGW * 64;
    unsigned char* ws = ws_base();
    for (int i = gt; i < SEQ * 48; i += NGT) {
        const bool isA = i < SEQ * 32; const int j = isA ? i : i - SEQ * 32, nf = isA ? 32 : 16, t = j / nf, f = j - t * nf;
        const double inv = exp(-((double)f / (double)nf) * 9.210340371976184); double s, c; dsincos((double)t * inv, s, c);
        if (isA) { ((float*)(ws + WS_COSA))[j] = (float)c; ((float*)(ws + WS_SINA))[j] = (float)s; } else { ((float*)(ws + WS_COSI))[j] = (float)c; ((float*)(ws + WS_SINI))[j] = (float)s; }
    }
    for (int i = gt; i < 12 * 192; i += NGT) {
        const int h = i / 192, rel = (i - h * 192) - 128, n = rel < 0 ? -rel : rel; int bk = rel > 0 ? 16 : 0;
        if (n < 8) bk += n; else { int lg = 8 + (int)(logf((float)n / 8.f) / 2.772588722239781f * 8.f); if (lg > 15) lg = 15; bk += lg; }
        ((float*)(ws + WS_T5))[i] = inp(I_RELB)[bk * 12 + h] * LOG2E;
    }
    for (int i = gt; i < DEPTH * 4096; i += NGT) {
        const int l = i >> 12, g = (i >> 6) & 63, n = i & 63; double ar, ai, cr, ci; s5_coef(F, l, g, n, ar, ai, cr, ci);
        float* pa = (float*)(ws + WS_S5P + l * S5P_STRIDE + S5P_A) + (g * 64 + n) * 2; pa[0] = (float)ar; pa[1] = (float)ai;
        double pr = ar, pi = ai;
#pragma unroll 1
        for (int k = 0; k < 9; ++k) { const double tr = pr * pr - pi * pi, ti = 2.0 * pr * pi; pr = tr; pi = ti; }
        float* pb = (float*)(ws + WS_S5P + l * S5P_STRIDE + S5P_A512) + (g * 64 + n) * 2; pb[0] = (float)pr; pb[1] = (float)pi;
    }
    for (int i = gt; i < DEPTH * 64 * 8 * 64; i += NGT) {
        const int l = i >> 15, g = (i >> 9) & 63, ct = (i >> 6) & 7, ln = i & 63, oc = ct * 16 + (ln & 15), n = oc & 63, kq = ln >> 4;
        u32x4 o = (u32x4){0u, 0u, 0u, 0u};
        if (kq < 2) { double ar, ai, cr, ci; s5_coef(F, l, g, n, ar, ai, cr, ci); unsigned hv[8];
#pragma unroll
            for (int j = 0; j < 8; ++j) { const int p = 8 * kq + j; const size_t bi = ((size_t)(l * 64 + g) * 64 + n) * 16 + p; const double br = inp(I_BRE)[bi], bim = inp(I_BIM)[bi];
                hv[j] = f2bf((float)(oc < 64 ? cr * br - ci * bim : cr * bim + ci * br)); }
            o.x = hv[0] | (hv[1] << 16); o.y = hv[2] | (hv[3] << 16); o.z = hv[4] | (hv[5] << 16); o.w = hv[6] | (hv[7] << 16); }
        *(u32x4*)(ws + WS_S5P + l * S5P_STRIDE + S5P_BB + ((size_t)(g * 8 + ct) * 64 + ln) * 16) = o;
    }
    for (int i = gt; i < DEPTH * 64 * 4 * 64; i += NGT) {
        const int l = i >> 14, g = (i >> 8) & 63, ks = (i >> 6) & 3, ln = i & 63, p = ln & 15; unsigned hv[8];
#pragma unroll
        for (int j = 0; j < 8; ++j) { const int k = 32 * ks + 8 * (ln >> 4) + j; const size_t ci_ = ((size_t)(l * 64 + g) * 16 + p) * 64 + (k & 63);
            hv[j] = f2bf(k < 64 ? inp(I_CRE)[ci_] : -inp(I_CIM)[ci_]); }
        u32x4 o; o.x = hv[0] | (hv[1] << 16); o.y = hv[2] | (hv[3] << 16); o.z = hv[4] | (hv[5] << 16); o.w = hv[6] | (hv[7] << 16);
        *(u32x4*)(ws + WS_S5P + l * S5P_STRIDE + S5P_CM + ((size_t)(g * 4 + ks) * 64 + ln) * 16) = o;
    }
    for (int i = gt; i < DEPTH * 112 * 512; i += NGT) { const int l = i / (112 * 512), r = i - l * 112 * 512;
        *(u32x4*)(ws + WS_W0 + l * W_LSTRIDE + W_IN + (size_t)NPROJ_USED * D * 2 + (size_t)r * 16) = (u32x4){0u, 0u, 0u, 0u}; }
    LAS float* scr = (LAS float*)(F.lds + F.wave * 16384);
    constexpr int IT_IN = (D / 64) * ((NPROJ_USED + 31) / 32), IT_UQ = (768 / 64) * (2304 / 32), IT_UKV = (512 / 64) * (3072 / 32), IT_GLU = (1024 / 64) * (1024 / 32),
                  IT_OUT = (D / 64) * (D / 32), IT_1 = (D / 64) * (DFF / 32), IT_2 = (DFF / 64) * (D / 32), IT_L = IT_IN + IT_UQ + IT_UKV + IT_GLU + IT_OUT + IT_1 + IT_2;
    for (int it = gw; it < DEPTH * IT_L; it += NGW) {
        const int l = it / IT_L; int r = it - l * IT_L; unsigned char* wl = ws + WS_W0 + l * W_LSTRIDE;
        if (r < IT_IN) { cvt_item<1>(inp(I_WIN) + (size_t)l * D * NPROJ_USED, D, NPROJ_USED, (bf16*)(wl + W_IN), nullptr, scr, r, F.lane); continue; } r -= IT_IN;
        if (r < IT_UQ) { cvt_item<2>(inp(I_AWUQ) + (size_t)l * 768 * 2304, 768, 2304, (bf16*)(wl + W_UQ), inp(I_AGQ) + l * 768, scr, r, F.lane); continue; } r -= IT_UQ;
        if (r < IT_UKV) { cvt_item<0>(inp(I_AWUKV) + (size_t)l * 512 * 3072, 512, 3072, (bf16*)(wl + W_UKV), inp(I_AGKV) + l * 512, scr, r, F.lane); continue; } r -= IT_UKV;
        if (r < IT_GLU) { cvt_item<0>(inp(I_WGLU) + (size_t)l * 1024 * 1024, 1024, 1024, (bf16*)(wl + W_GLU), nullptr, scr, r, F.lane); continue; } r -= IT_GLU;
        if (r < IT_OUT) { cvt_item<0>(inp(I_WOUT) + (size_t)l * D * D, D, D, (bf16*)(wl + W_OUT), nullptr, scr, r, F.lane); continue; } r -= IT_OUT;
        if (r < IT_1) { cvt_item<0>(inp(I_WFF1) + (size_t)l * D * DFF, D, DFF, (bf16*)(wl + W_1), nullptr, scr, r, F.lane); continue; } r -= IT_1;
        cvt_item<0>(inp(I_WFF2) + (size_t)l * DFF * D, DFF, D, (bf16*)(wl + W_2), nullptr, scr, r, F.lane);
    }
    ln_phase(F, inp(I_X), inp(I_LNG), inp(I_LNB));
}
constexpr int S5_WLDS = 8192 + 16 * 272;
template <bool OUT>
__device__ __forceinline__ void s5_task(Frame& F, int layer, int b, int g, int o, LAS unsigned char* wl) {
    const int lane = F.lane, kq = lane >> 4, p = lane & 15;
    const unsigned char* sp = ws_base() + WS_S5P + layer * S5P_STRIDE;
    const float ar = ((const float*)(sp + S5P_A))[(g * 64 + lane) * 2], ai = ((const float*)(sp + S5P_A))[(g * 64 + lane) * 2 + 1];
    bf16x8 bbf[8];
#pragma unroll
    for (int ct = 0; ct < 8; ++ct) bbf[ct] = *(const bf16x8*)(sp + S5P_BB + ((size_t)(g * 8 + ct) * 64 + lane) * 16);
    bf16x8 cmf[4]; float dsk = 0.f;
    float* E = (float*)(ws_base() + WS_E);
    float hr = 0.f, hi = 0.f;
    if (OUT) {
#pragma unroll
        for (int ks = 0; ks < 4; ++ks) cmf[ks] = *(const bf16x8*)(sp + S5P_CM + ((size_t)(g * 4 + ks) * 64 + lane) * 16);
        dsk = inp(I_SD)[(layer * 64 + g) * 16 + p];
        const float pr = ((const float*)(sp + S5P_A512))[(g * 64 + lane) * 2], pi = ((const float*)(sp + S5P_A512))[(g * 64 + lane) * 2 + 1];
        for (int oo = 0; oo < o; ++oo) { const float er = E[((size_t)(b * 64 + g) * 8 + oo) * 128 + lane], ei = E[((size_t)(b * 64 + g) * 8 + oo) * 128 + 64 + lane];
            const float nr = pr * hr - pi * hi + er, ni = pr * hi + pi * hr + ei; hr = nr; hi = ni; }
    }
    LAS float* BUf = (LAS float*)wl; LAS unsigned short* Hs = (LAS unsigned short*)(wl + 8192);
    const bf16* PROJ = (const bf16*)(ws_base() + WS_PROJ); bf16* G = (bf16*)(ws_base() + WS_G);
    const size_t r0 = (size_t)b * SEQ + (size_t)o * 512;
    const bf16* up = PROJ + (r0 + p) * NPROJ + C_USSM + 16 * g + 8 * (kq & 1);
    bf16x8 nxt = (bf16x8){0, 0, 0, 0, 0, 0, 0, 0};
    if (kq < 2) nxt = *(const bf16x8*)up;
    for (int it = 0; it < 32; ++it) {
        const bf16x8 cur = nxt;
        if (it + 1 < 32 && kq < 2) nxt = *(const bf16x8*)(up + (size_t)(it + 1) * 16 * NPROJ);
#pragma unroll
        for (int ct = 0; ct < 8; ++ct) { const f32x4 c = __builtin_amdgcn_mfma_f32_16x16x32_bf16(cur, bbf[ct], (f32x4){0.f, 0.f, 0.f, 0.f}, 0, 0, 0);
#pragma unroll
            for (int r = 0; r < 4; ++r) BUf[(kq * 4 + r) * 128 + ct * 16 + p] = c[r]; }
        asm volatile("" ::: "memory");
#pragma unroll
        for (int ps = 0; ps < 16; ++ps) { const float br = BUf[ps * 128 + lane], bi = BUf[ps * 128 + 64 + lane];
            const float nr = ar * hr - ai * hi + br, ni = ar * hi + ai * hr + bi; hr = nr; hi = ni;
            if (OUT) { Hs[ps * 136 + lane] = (unsigned short)f2bf(hr); Hs[ps * 136 + 64 + lane] = (unsigned short)f2bf(hi); } }
        asm volatile("" ::: "memory");
        if (OUT) {
            f32x4 y = (f32x4){0.f, 0.f, 0.f, 0.f};
#pragma unroll
            for (int ks = 0; ks < 4; ++ks) { const bf16x8 a = *(const LAS bf16x8*)(Hs + p * 136 + 32 * ks + 8 * kq); y = __builtin_amdgcn_mfma_f32_16x16x32_bf16(a, cmf[ks], y, 0, 0, 0); }
#pragma unroll
            for (int r = 0; r < 4; ++r) { const size_t row = r0 + it * 16 + kq * 4 + r; const float u = bf2f(PROJ[row * NPROJ + C_USSM + 16 * g + p]);
                const float v = y[r] + dsk * u, z = 0.7978845608028654f * (v + 0.044715f * v * v * v);
                G[row * 1024 + 16 * g + p] = (bf16)f2bf(v / (1.f + __expf(-2.f * z))); }
            asm volatile("" ::: "memory");
        }
    }
    if (!OUT) { E[((size_t)(b * 64 + g) * 8 + o) * 128 + lane] = hr; E[((size_t)(b * 64 + g) * 8 + o) * 128 + 64 + lane] = hi; }
}
template <bool OUT>
__device__ __forceinline__ void s5_phase(Frame& F, int layer) {
    const int gw = F.vcu * 8 + F.wave, NGW = F.G * 8;
    LAS unsigned char* wl = F.lds + F.wave * S5_WLDS;
    for (int task = gw; task < NB * 64 * 8; task += NGW) { const int o = task & 7, g = (task >> 3) & 63, b = task >> 9;
        if (!OUT && o == 7) continue;
        s5_task<OUT>(F, layer, b, g, o, wl); }
}

__device__ __forceinline__ void dsa_index_phase(Frame& F, int qword) {
    const int lane = F.lane, wave = F.wave, r32 = lane & 31, hi = lane >> 5;
    const bf16* PROJ = (const bf16*)(ws_base() + WS_PROJ); u64* MASK = (u64*)(ws_base() + WS_MASK);
    LAS unsigned* sc = (LAS unsigned*)F.lds;
    volatile LAS unsigned* qs = (volatile LAS unsigned*)(F.lds + LDSCTL_OFF + 64);
    for (;;) {
        if (F.tid == 0) qs[0] = __hip_atomic_fetch_add(ctl_base() + CW_Q + 64 * qword, 1u, RLX_AGENT);
        __syncthreads();
        const unsigned idx = qs[0];
        __syncthreads();
        if (idx >= 2048u) break;
        const int t0 = 4088 - 8 * (int)(idx >> 2), b = (int)(idx & 3u), lim = 64 * ((t0 >> 6) + 1), nk64 = lim >> 6;
        const size_t rowq = (size_t)b * SEQ + t0;
        if (lim <= 256) { MASK[(rowq + wave) * 64 + lane] = lane < nk64 ? ~0ull : 0ull; continue; }
#pragma unroll 1
        for (int hb = 0; hb < 2; ++hb) {
            bf16x8 afr[2][4]; float wq[2][16];
#pragma unroll
            for (int bl = 0; bl < 2; ++bl)
#pragma unroll
                for (int ks = 0; ks < 4; ++ks) afr[bl][ks] = *(const bf16x8*)(PROJ + (rowq + 4 * hb + 2 * bl + (r32 >> 4)) * NPROJ + C_QI + (r32 & 15) * 64 + ks * 16 + 8 * hi);
#pragma unroll
            for (int bl = 0; bl < 2; ++bl)
#pragma unroll
                for (int r = 0; r < 16; ++r) wq[bl][r] = bf2f(PROJ[(rowq + 4 * hb + 2 * bl + (r >> 3)) * NPROJ + C_WI + (r & 3) + 8 * ((r >> 2) & 1) + 4 * hi]);
            const int ntile = lim >> 5;
            const bf16* kp = PROJ + ((size_t)b * SEQ + r32) * NPROJ + C_KI + 8 * hi;
            bf16x8 bn[4];
            if (wave < ntile) {
#pragma unroll
                for (int ks = 0; ks < 4; ++ks) bn[ks] = *(const bf16x8*)(kp + (size_t)wave * 32 * NPROJ + ks * 16);
            }
            for (int kt = wave; kt < ntile; kt += 8) {
                bf16x8 bc[4];
#pragma unroll
                for (int ks = 0; ks < 4; ++ks) bc[ks] = bn[ks];
                if (kt + 8 < ntile) {
#pragma unroll
                    for (int ks = 0; ks < 4; ++ks) bn[ks] = *(const bf16x8*)(kp + (size_t)(kt + 8) * 32 * NPROJ + ks * 16);
                }
#pragma unroll
                for (int bl = 0; bl < 2; ++bl) {
                    f32x16 c = {};
#pragma unroll
                    for (int ks = 0; ks < 4; ++ks) c = __builtin_amdgcn_mfma_f32_32x32x16_bf16(afr[bl][ks], bc[ks], c, 0, 0, 0);
                    float sA = 0.f, sB = 0.f;
#pragma unroll
                    for (int r = 0; r < 8; ++r) { sA += fmaxf(c[r], 0.f) * wq[bl][r]; sB += fmaxf(c[8 + r], 0.f) * wq[bl][8 + r]; }
                    auto rr = __builtin_amdgcn_permlane32_swap(__float_as_uint(sA), __float_as_uint(sB), false, false);
                    const float tot = __uint_as_float(rr[0]) + __uint_as_float(rr[1]);
                    unsigned ub = __float_as_uint(tot); ub = (ub & 0x80000000u) ? ~ub : (ub | 0x80000000u);
                    sc[(4 * hb + 2 * bl + hi) * 4096 + kt * 32 + r32] = ub;
                }
            }
        }
        __syncthreads();
        {
            unsigned kv[64];
#pragma unroll
            for (int i = 0; i < 64; ++i) { const unsigned v = sc[wave * 4096 + i * 64 + lane]; kv[i] = i < nk64 ? v : 0u; }
            unsigned T = 0u;
#pragma unroll 1
            for (int bit = 31; bit >= 0; --bit) {
                const unsigned cand = T | (1u << bit); int cnt = 0;
#pragma unroll
                for (int i = 0; i < 64; ++i) cnt += __builtin_popcountll(__ballot(kv[i] >= cand));
                if (cnt >= 256) T = cand;
            }
            int gt = 0;
#pragma unroll
            for (int i = 0; i < 64; ++i) gt += __builtin_popcountll(__ballot(kv[i] > T));
            int need = 256 - gt; u64 mine = 0ull;
#pragma unroll
            for (int i = 0; i < 64; ++i) {
                u64 eq = __ballot(kv[i] == T); const u64 g1 = __ballot(kv[i] > T);
                const int ce = __builtin_popcountll(eq);
                if (ce > need) { u64 t = eq, kept = 0ull; for (int c = 0; c < need; ++c) { const u64 low = t & (0ull - t); kept |= low; t ^= low; } eq = kept; need = 0; }
                else need -= ce;
                const u64 w = g1 | eq;
                if (lane == i) mine = w;
            }
            MASK[(rowq + wave) * 64 + lane] = mine;
        }
        __syncthreads();
    }
}
namespace fa {
constexpr int SHM_V = 16384;
#define KSWZ(row, colB) ((row) * 256 + ((colB) ^ (((row) & 7) << 4)))
#define SBAR() __builtin_amdgcn_sched_barrier(0)
__device__ __forceinline__ int v_st(int k, int c) { const int kk = (k & ~0xC) | ((k & 4) << 1) | ((k & 8) >> 1); return ((kk >> 3) * 4 + (c >> 5)) * 512 + ((kk & 7) * 32 + (c & 31)) * 2; }
__device__ __forceinline__ int v_rd_base(int lane) { return ((lane & 3) << 3) | (((lane >> 2) & 3) << 6) | (((lane >> 4) & 1) << 5) | (((lane >> 5) & 1) << 8); }
constexpr int v_rd_off(int d0, int ks, int half) { return d0 * 512 + ks * 4096 + half * 2048; }
__device__ __forceinline__ int crow(int r, int hi) { return (r & 3) + 8 * (r >> 2) + 4 * hi; }
struct Args {
    const bf16* Q; int ldq; const bf16* Qr;
    const bf16* K; int ldk; const bf16* Kr; int ldkr; const bf16* V; int ldv;
    bf16* O; int ldo;
    const u64* mask; const float* t5;
};
template <int DQK, bool DSA>
struct State { bf16x8 qr[DQK / 16]; f32x16 o[4]; float m, l; bf16x8 sk0, sk1, sv0, sv1, skr; };

template <int DQK, bool DSA, int BUF>
__device__ __forceinline__ void step(const Args& A, State<DQK, DSA>& S, int t, int NT, int my_last, int q0, char* lds, int tid) {
    constexpr int SHM_K = 64 * DQK * 2;
    const int wid = __builtin_amdgcn_readfirstlane(tid >> 6), lane = tid & 63, r32 = lane & 31, hi = lane >> 5;
    char* V_lds = lds; char* K_lds = lds + 2 * SHM_V;
    float* wsf = (float*)(lds + 2 * SHM_V + 2 * SHM_K) + wid * 64; float* al_l = wsf + 32;
    const float* t5l = (const float*)(lds + 2 * SHM_V + 2 * SHM_K + 2048);
    int tid2 = tid; asm volatile("" : "+v"(tid2));
    const int sr = tid2 >> 4, scc = (tid2 & 15) * 8;
    const bool more = t + 1 < NT;
    if (more) { const size_t k1 = (size_t)(t + 1) * 64;         S.sv0 = *(const bf16x8*)(A.V + (k1 + sr) * A.ldv + scc); S.sv1 = *(const bf16x8*)(A.V + (k1 + 32 + sr) * A.ldv + scc);         S.sk0 = *(const bf16x8*)(A.K + (k1 + sr) * A.ldk + scc); S.sk1 = *(const bf16x8*)(A.K + (k1 + 32 + sr) * A.ldk + scc);         if (DQK == 192) S.skr = *(const bf16x8*)(A.Kr + (k1 + (tid2 >> 3)) * A.ldkr + (tid2 & 7) * 8); }
    if (t <= my_last) {
        u64 mw = 0ull; const int tq = q0 + wid * 32 + r32;
        if (DSA) mw = A.mask[(size_t)tq * 64 + t];
        SBAR();
        f32x16 p0 = {}, p1 = {};
        { const char* kb[4];
#pragma unroll
          for (int dd = 0; dd < 4; ++dd) kb[dd] = K_lds + BUF * SHM_K + KSWZ(r32, (dd * 16 + hi * 8) * 2);
#pragma unroll
          for (int d0 = 0; d0 < 8; ++d0) { const char* a = kb[d0 & 3] + (d0 >> 2) * 128;
              const bf16x8 b0 = *(const bf16x8*)a, b1 = *(const bf16x8*)(a + 32 * 256);
              p0 = __builtin_amdgcn_mfma_f32_32x32x16_bf16(b0, S.qr[d0], p0, 0, 0, 0); p1 = __builtin_amdgcn_mfma_f32_32x32x16_bf16(b1, S.qr[d0], p1, 0, 0, 0); }
          if (DQK == 192) {
#pragma unroll
              for (int d0 = 0; d0 < 4; ++d0) { const char* a = K_lds + BUF * SHM_K + 16384 + r32 * 128 + ((d0 * 32 + hi * 16) ^ ((r32 & 7) << 4));
                  const bf16x8 b0 = *(const bf16x8*)a, b1 = *(const bf16x8*)(a + 32 * 128);
                  p0 = __builtin_amdgcn_mfma_f32_32x32x16_bf16(b0, S.qr[8 + d0], p0, 0, 0, 0); p1 = __builtin_amdgcn_mfma_f32_32x32x16_bf16(b1, S.qr[8 + d0], p1, 0, 0, 0); } }
        }
        if (DSA) {
            const float NEG = -__builtin_inff();
            const int kbase = t * 64, maxrel = kbase + 63 - (q0 + wid * 32);
            const unsigned lo = (unsigned)mw >> (4 * hi), hh = (unsigned)(mw >> 32) >> (4 * hi);
            if (maxrel <= -91) { const float bc = t5l[0];
#pragma unroll
                for (int r = 0; r < 16; ++r) { const int c = (r & 3) + 8 * (r >> 2); p0[r] = ((lo >> c) & 1u) ? p0[r] + bc : NEG; p1[r] = ((hh >> c) & 1u) ? p1[r] + bc : NEG; } }
            else { const int rb = kbase + 4 * hi - tq + 128;
#pragma unroll
                for (int r = 0; r < 16; ++r) { const int c = (r & 3) + 8 * (r >> 2); int i0 = rb + c, i1 = rb + c + 32; i0 = i0 < 0 ? 0 : i0; i1 = i1 < 0 ? 0 : i1;
                    p0[r] = ((lo >> c) & 1u) ? p0[r] + t5l[i0] : NEG; p1[r] = ((hh >> c) & 1u) ? p1[r] + t5l[i1] : NEG; } }
        }
        float pmax = p0[0];
#pragma unroll
        for (int r = 1; r < 16; ++r) pmax = fmaxf(pmax, p0[r]);
#pragma unroll
        for (int r = 0; r < 16; ++r) pmax = fmaxf(pmax, p1[r]);
        { auto rr = __builtin_amdgcn_permlane32_swap(__float_as_uint(pmax), __float_as_uint(pmax), false, false); pmax = fmaxf(__uint_as_float(rr[0]), __uint_as_float(rr[1])); }
        float alpha = 1.f;
        if (!__all(pmax - S.m <= 8.f)) { const float mn = fmaxf(S.m, pmax); alpha = __builtin_amdgcn_exp2f(S.m - mn); S.m = mn; }
        const float mcur = S.m;
#pragma unroll
        for (int r = 0; r < 16; ++r) { p0[r] = __builtin_amdgcn_exp2f(p0[r] - mcur); p1[r] = __builtin_amdgcn_exp2f(p1[r] - mcur); }
        float ps = 0.f;
#pragma unroll
        for (int r = 0; r < 16; ++r) ps += p0[r] + p1[r];
        { auto rr = __builtin_amdgcn_permlane32_swap(__float_as_uint(ps), __float_as_uint(ps), false, false); ps = __uint_as_float(rr[0]) + __uint_as_float(rr[1]); }
        S.l = S.l * alpha + ps;
        bf16x8 pa0, pa1, pa2, pa3;
#define PK4(P, B_, OUT) do { unsigned a0 = cvtpk(P[B_+0], P[B_+1]), a1 = cvtpk(P[B_+2], P[B_+3]); unsigned b0 = cvtpk(P[B_+4], P[B_+5]), b1 = cvtpk(P[B_+6], P[B_+7]); \
        auto r0 = __builtin_amdgcn_permlane32_swap(a0, b0, false, false); auto r1 = __builtin_amdgcn_permlane32_swap(a1, b1, false, false); \
        u32x4 w = {r0[0], r1[0], r0[1], r1[1]}; OUT = __builtin_bit_cast(bf16x8, w); } while (0)
        PK4(p0, 0, pa0); PK4(p0, 8, pa1); PK4(p1, 0, pa2); PK4(p1, 8, pa3);
#undef PK4
        if (__any(alpha < 1.f)) { if (hi == 0) al_l[r32] = alpha; asm volatile("s_waitcnt lgkmcnt(0)" ::: "memory");
#pragma unroll
            for (int d_ = 0; d_ < 4; ++d_)
#pragma unroll
                for (int r = 0; r < 16; ++r) S.o[d_][r] *= al_l[crow(r, hi)]; }
        const int vb0 = (int)(uintptr_t)V_lds + v_rd_base(lane);
#define TRRD(dst, off) asm volatile("ds_read_b64_tr_b16 %0, %1 offset:%2" : "=&v"(dst) : "v"(vb0), "i"(off) : "memory")
#define PV_D0(d0) do { s16x4 l0, l1, l2, l3, h0, h1, h2, h3; constexpr int b_ = BUF * SHM_V + v_rd_off(d0, 0, 0); \
        TRRD(l0, b_); TRRD(h0, b_ + 2048); TRRD(l1, b_ + 4096); TRRD(h1, b_ + 6144); TRRD(l2, b_ + 8192); TRRD(h2, b_ + 10240); TRRD(l3, b_ + 12288); TRRD(h3, b_ + 14336); \
        asm volatile("s_waitcnt lgkmcnt(0)" ::: "memory"); SBAR(); \
        S.o[d0] = __builtin_amdgcn_mfma_f32_32x32x16_bf16(pa0, (bf16x8){l0[0], l0[1], l0[2], l0[3], h0[0], h0[1], h0[2], h0[3]}, S.o[d0], 0, 0, 0); \
        S.o[d0] = __builtin_amdgcn_mfma_f32_32x32x16_bf16(pa1, (bf16x8){l1[0], l1[1], l1[2], l1[3], h1[0], h1[1], h1[2], h1[3]}, S.o[d0], 0, 0, 0); \
        S.o[d0] = __builtin_amdgcn_mfma_f32_32x32x16_bf16(pa2, (bf16x8){l2[0], l2[1], l2[2], l2[3], h2[0], h2[1], h2[2], h2[3]}, S.o[d0], 0, 0, 0); \
        S.o[d0] = __builtin_amdgcn_mfma_f32_32x32x16_bf16(pa3, (bf16x8){l3[0], l3[1], l3[2], l3[3], h3[0], h3[1], h3[2], h3[3]}, S.o[d0], 0, 0, 0); } while (0)
        PV_D0(0); PV_D0(1); PV_D0(2); PV_D0(3);
#undef PV_D0
#undef TRRD
    }
    if (more) { asm volatile("s_waitcnt vmcnt(0)" ::: "memory");
        constexpr int NB_ = BUF ^ 1; const int kws = KSWZ(sr, scc * 2);
        *(bf16x8*)(V_lds + NB_ * SHM_V + v_st(sr, scc)) = S.sv0; *(bf16x8*)(V_lds + NB_ * SHM_V + v_st(32 + sr, scc)) = S.sv1;
        *(bf16x8*)(K_lds + NB_ * SHM_K + kws) = S.sk0; *(bf16x8*)(K_lds + NB_ * SHM_K + kws + 32 * 256) = S.sk1;
        if (DQK == 192) { const int rr_ = tid2 >> 3; *(bf16x8*)(K_lds + NB_ * SHM_K + 16384 + rr_ * 128 + (((tid2 & 7) * 16) ^ ((rr_ & 7) << 4))) = S.skr; } }
    __syncthreads();
}

template <int DQK, bool DSA>
__device__ __forceinline__ void unit(const Args& A, int qb, char* lds) {
    constexpr int SHM_K = 64 * DQK * 2;
    int tid_ = threadIdx.x; asm volatile("" : "+v"(tid_));
    const int tid = tid_, wid = __builtin_amdgcn_readfirstlane(tid >> 6), lane = tid & 63, r32 = lane & 31, hi = lane >> 5;
    const int q0 = qb * 256, NT = 4 * qb + 4, my_last = 4 * qb + (wid >> 1);
    char* V_lds = lds; char* K_lds = lds + 2 * SHM_V;
    float* wsf = (float*)(lds + 2 * SHM_V + 2 * SHM_K) + wid * 64;
    State<DQK, DSA> S;
    const bf16* qp = A.Q + (size_t)(q0 + wid * 32 + r32) * A.ldq + hi * 8;
#pragma unroll
    for (int d0 = 0; d0 < 8; ++d0) S.qr[d0] = *(const bf16x8*)(qp + d0 * 16);
    if (DQK == 192) { const bf16* qrp = A.Qr + (size_t)(q0 + wid * 32 + r32) * A.ldq + hi * 8;
#pragma unroll
        for (int d0 = 0; d0 < 4; ++d0) S.qr[8 + d0] = *(const bf16x8*)(qrp + d0 * 16); }
    if (DSA) { float* t5l = (float*)(lds + 2 * SHM_V + 2 * SHM_K + 2048); if (tid < 192) t5l[tid] = A.t5[tid]; }
    S.m = -1e30f; S.l = 0.f;
#pragma unroll
    for (int d = 0; d < 4; ++d) S.o[d] = f32x16{};
    { const int sr = tid >> 4, scc = (tid & 15) * 8, kws = KSWZ(sr, scc * 2);
      const bf16x8 v0 = *(const bf16x8*)(A.V + (size_t)sr * A.ldv + scc), v1 = *(const bf16x8*)(A.V + (size_t)(32 + sr) * A.ldv + scc);
      const bf16x8 k0 = *(const bf16x8*)(A.K + (size_t)sr * A.ldk + scc), k1 = *(const bf16x8*)(A.K + (size_t)(32 + sr) * A.ldk + scc);
      *(bf16x8*)(V_lds + v_st(sr, scc)) = v0; *(bf16x8*)(V_lds + v_st(32 + sr, scc)) = v1;
      *(bf16x8*)(K_lds + kws) = k0; *(bf16x8*)(K_lds + kws + 32 * 256) = k1;
      if (DQK == 192) { const int rr_ = tid >> 3; const bf16x8 kr = *(const bf16x8*)(A.Kr + (size_t)rr_ * A.ldkr + (tid & 7) * 8);
          *(bf16x8*)(K_lds + 16384 + rr_ * 128 + (((tid & 7) * 16) ^ ((rr_ & 7) << 4))) = kr; } }
    __syncthreads();
    for (int t = 0; t < NT; t += 2) { step<DQK, DSA, 0>(A, S, t, NT, my_last, q0, lds, tid); step<DQK, DSA, 1>(A, S, t + 1, NT, my_last, q0, lds, tid); }
    float* li_l = wsf;
    if (hi == 0) li_l[r32] = S.l; asm volatile("s_waitcnt lgkmcnt(0)" ::: "memory");
    float rli[16];
#pragma unroll
    for (int r = 0; r < 16; ++r) rli[r] = __builtin_amdgcn_rcpf(li_l[crow(r, hi)]);
    bf16* Ow = A.O + (size_t)(q0 + wid * 32) * A.ldo;
#pragma unroll
    for (int r = 0; r < 16; ++r) { const int orow = crow(r, hi);
#pragma unroll
        for (int d0 = 0; d0 < 4; ++d0) { const float v = S.o[d0][r] * rli[r]; const float vn = __shfl_xor(v, 1);
            if ((r32 & 1) == 0) *(unsigned*)(Ow + (size_t)orow * A.ldo + d0 * 32 + r32) = cvtpk(v, vn); } }
    __syncthreads();
}
#undef KSWZ
#undef SBAR
}

template <bool DSA>
__device__ __forceinline__ void attn_phase(Frame& F, int qbase) {
    volatile LAS unsigned* qs = (volatile LAS unsigned*)(F.lds + LDSCTL_OFF + 64);
    const bf16* PROJ = (const bf16*)(ws_base() + WS_PROJ); const bf16* QA = (const bf16*)(ws_base() + WS_QA); const bf16* KV = (const bf16*)(ws_base() + WS_KV); bf16* MIX = (bf16*)(ws_base() + WS_MIX);
    int x = (int)((unsigned)__builtin_amdgcn_s_getreg((3 << 11) | 20) & 7u), tries = 0;
    while (tries < 8) {
        if (F.tid == 0) qs[0] = __hip_atomic_fetch_add(ctl_base() + CW_Q + 64 * (qbase + x), 1u, RLX_AGENT);
        __syncthreads();
        const unsigned idx = qs[0];
        __syncthreads();
        if (idx >= 96u) { x = (x + 1) & 7; ++tries; continue; }
        const int bh = x * 6 + (int)(idx >> 4), qb = 15 - (int)(idx & 15u), b = bh / 12, h = bh - b * 12;
        const size_t rb = (size_t)b * SEQ;
        fa::Args A;
        if (!DSA) { A.Q = QA + rb * NQA + h * 128; A.ldq = NQA; A.Qr = QA + rb * NQA + 1536 + h * 64; A.K = KV + rb * NKV + h * 256; A.ldk = NKV; A.Kr = PROJ + rb * NPROJ + C_KROPE; A.ldkr = NPROJ;
            A.V = KV + rb * NKV + h * 256 + 128; A.ldv = NKV; A.O = MIX + rb * D + h * 128; A.ldo = D; A.mask = nullptr; A.t5 = nullptr;
            fa::unit<192, false>(A, qb, (char*)F.lds); }
        else { A.Q = PROJ + rb * NPROJ + C_QC + h * 128; A.ldq = NPROJ; A.Qr = nullptr; A.K = PROJ + rb * NPROJ + C_KC; A.ldk = NPROJ; A.Kr = nullptr; A.ldkr = 0;
            A.V = PROJ + rb * NPROJ + C_VC; A.ldv = NPROJ; A.O = MIX + rb * D + 2560 + h * 128; A.ldo = D; A.mask = (const u64*)(ws_base() + WS_MASK) + rb * 64; A.t5 = (const float*)(ws_base() + WS_T5) + h * 192;
            fa::unit<128, true>(A, qb, (char*)F.lds); }
    }
}
struct KArgs { const float* in[26]; float* out; unsigned char* ws; };
static_assert(sizeof(KArgs) == 224, "kernarg layout");
constexpr int NWAVES = 8;
#ifndef PHASE_MASK
#define PHASE_MASK 0xFFFF
#endif
__global__ void __launch_bounds__(NWAVES * 64, 2) trunk_fwd(KArgs args) {
    extern __shared__ __attribute__((aligned(16))) unsigned char lds_raw[];
    Frame F;
    F.lds = (LAS unsigned char*)lds_raw;
#define RELAUNDER() do { int t_ = threadIdx.x; asm volatile("" : "+v"(t_)); F.tid = t_; F.lane = t_ & 63; F.wave = __builtin_amdgcn_readfirstlane(t_ >> 6); } while (0)
    RELAUNDER();
    F.G = gridDim.x; { const int bx = blockIdx.x; F.vcu = (F.G % 8 == 0) ? (bx % 8) * (F.G / 8) + bx / 8 : bx; }
    for (int u = F.tid; u < (LDS_BYTES - LDSCTL_OFF) / 4; u += NWAVES * 64) ((LAS unsigned*)(F.lds + LDSCTL_OFF))[u] = 0u;
    __syncthreads();
    (void)xcd_barrier_post(ctl_base() + CW_BAR, (volatile LAS unsigned*)(F.lds + LDSCTL_OFF));
#define GRID_BAR() do { XcdBarrier b_; b_.bar = ctl_base() + CW_BAR; b_.x = xb_xcc_id(); b_.st = (volatile LAS unsigned*)(F.lds + LDSCTL_OFF); xcd_barrier(b_); } while (0)
    unsigned char* ws = ws_base();
    bf16* HB = (bf16*)(ws + WS_HB); bf16* PROJ = (bf16*)(ws + WS_PROJ); bf16* QA = (bf16*)(ws + WS_QA); bf16* KVb = (bf16*)(ws + WS_KV);
    bf16* Gb = (bf16*)(ws + WS_G); bf16* MIX = (bf16*)(ws + WS_MIX); bf16* FFH = (bf16*)(ws + WS_FFH); float* SS = (float*)(ws + WS_SS);
    const float* cosA = (const float*)(ws + WS_COSA); const float* sinA = (const float*)(ws + WS_SINA); const float* cosI = (const float*)(ws + WS_COSI); const float* sinI = (const float*)(ws + WS_SINI);

    p0_prologue(F);
    GRID_BAR();
#pragma unroll 1
    for (int l = 0; l < DEPTH; ++l) {
        unsigned char* wl = ws + WS_W0 + (size_t)l * W_LSTRIDE;
        { pg8::Gemm g{HB, (const bf16*)(wl + W_IN), M, NPROJ, D, D}; pg8::StaticOrder S; S.init(M, NPROJ, F.G, (int)blockIdx.x);
          pg8::EpiProj E{PROJ, SS, cosA, sinA, cosI, sinI};
          pg8::gemm_phase<pg8::EpiProj, pg8::StaticOrder, true, true>(F.lds, g, S, E); }
        GRID_BAR();
        if (PHASE_MASK & 1) {
          { pg8::Gemm g{PROJ + C_QLAT, (const bf16*)(wl + W_UQ), M, NQA, 768, NPROJ}; pg8::StaticOrder S; S.init(M, NQA, F.G, (int)blockIdx.x);
            pg8::EpiUp<true> E{QA, SS, cosA, sinA};
            pg8::gemm_phase<pg8::EpiUp<true>, pg8::StaticOrder, true, true>(F.lds, g, S, E); }
          { pg8::Gemm g{PROJ + C_KVLAT, (const bf16*)(wl + W_UKV), M, NKV, 512, NPROJ}; pg8::StaticOrder S; S.init(M, NKV, F.G, (int)blockIdx.x);
            pg8::EpiUp<false> E{KVb, SS, cosA, sinA};
            pg8::gemm_phase<pg8::EpiUp<false>, pg8::StaticOrder, true, true>(F.lds, g, S, E); }
        }
        RELAUNDER(); if (PHASE_MASK & 2) s5_phase<false>(F, l);
        RELAUNDER(); if (PHASE_MASK & 4) dsa_index_phase(F, l * 32 + 0);
        GRID_BAR();
        RELAUNDER(); if (PHASE_MASK & 2) s5_phase<true>(F, l);
        RELAUNDER(); if (PHASE_MASK & 1) attn_phase<false>(F, l * 32 + 8);
        GRID_BAR();
        if (PHASE_MASK & 2) {
          pg8::Gemm g{Gb, (const bf16*)(wl + W_GLU), M, 1024, 1024, 1024}; pg8::StaticOrder S; S.init(M, 1024, F.G, (int)blockIdx.x);
          pg8::EpiGlu E{MIX, Gb, inp(I_BGLU) + l * 1024};
          pg8::gemm_phase<pg8::EpiGlu, pg8::StaticOrder, true, true>(F.lds, g, S, E); }
        RELAUNDER(); if (PHASE_MASK & 4) attn_phase<true>(F, l * 32 + 16);
        GRID_BAR();
        { pg8::Gemm g{MIX, (const bf16*)(wl + W_OUT), M, D, D, D}; pg8::StaticOrder S; S.init(M, D, F.G, (int)blockIdx.x);
          pg8::EpiRes E{x_base()};
          pg8::gemm_phase<pg8::EpiRes, pg8::StaticOrder, true, true>(F.lds, g, S, E); }
        GRID_BAR();
        RELAUNDER(); ln_phase(F, x_base(), inp(I_LN1G) + l * D, inp(I_LN1B) + l * D);
        GRID_BAR();
        { pg8::Gemm g{HB, (const bf16*)(wl + W_1), M, DFF, D, D}; pg8::StaticOrder S; S.init(M, DFF, F.G, (int)blockIdx.x);
          pg8::EpiRelu2 E{FFH};
          pg8::gemm_phase<pg8::EpiRelu2, pg8::StaticOrder, true, true>(F.lds, g, S, E); }
        GRID_BAR();
        { pg8::Gemm g{FFH, (const bf16*)(wl + W_2), M, D, DFF, DFF}; pg8::StaticOrder S; S.init(M, D, F.G, (int)blockIdx.x);
          pg8::EpiRes E{x_base()};
          pg8::gemm_phase<pg8::EpiRes, pg8::StaticOrder, true, true>(F.lds, g, S, E); }
        GRID_BAR();
        RELAUNDER(); ln_phase(F, x_base(), inp(I_LN2G) + l * D, inp(I_LN2B) + l * D);
        if (l + 1 < DEPTH) GRID_BAR();
    }
}

extern "C" void kernel_launch(void* const* d_in, const int* in_sizes, int n_in, void* d_out, int out_size, void* d_ws, size_t ws_size, hipStream_t stream) {
    static int grid = 0;
    if (grid == 0) {
        if (n_in != 26 || in_sizes[0] != M * D || out_size != M * D || ws_size < WS_END) { fprintf(stderr, "kernel_launch: unexpected shapes (n_in %d, out %d, ws %zu)\n", n_in, out_size, ws_size); grid = -1; return; }
        int dev = 0, cus = 0;
        if (hipGetDevice(&dev) != hipSuccess || hipDeviceGetAttribute(&cus, hipDeviceAttributeMultiprocessorCount, dev) != hipSuccess) { grid = -1; return; }
        if (hipFuncSetAttribute((const void*)trunk_fwd, hipFuncAttributeMaxDynamicSharedMemorySize, LDS_BYTES) != hipSuccess) { fprintf(stderr, "kernel_launch: hipFuncSetAttribute failed\n"); grid = -1; return; }
        int per_cu = 0;
        if (hipOccupancyMaxActiveBlocksPerMultiprocessor(&per_cu, (const void*)trunk_fwd, NWAVES * 64, LDS_BYTES) != hipSuccess || per_cu < 1) { fprintf(stderr, "kernel_launch: occupancy query says %d\n", per_cu); }
        (void)hipGetLastError();
        grid = cus;
    }
    if (grid < 0) return;
    if (hipMemsetAsync((char*)d_ws + WS_CTL, 0, CTL_BYTES, stream) != hipSuccess) return;
    KArgs a{};
    for (int i = 0; i < 26; ++i) a.in[i] = (const float*)d_in[i];
    a.out = (float*)d_out; a.ws = (unsigned char*)d_ws;
    hipLaunchKernelGGL(trunk_fwd, dim3(grid), dim3(NWAVES * 64), LDS_BYTES, stream, a);
}
```

```cpp
#include <hip/hip_runtime.h>
#include <cstdio>
#include <cstdint>
#include <cmath>

#define LAS __attribute__((address_space(3)))
#define GAS __attribute__((address_space(1)))
typedef unsigned short bf16;
typedef short bf16x8 __attribute__((ext_vector_type(8)));
typedef short s16x4 __attribute__((ext_vector_type(4)));
typedef float f32x2 __attribute__((ext_vector_type(2)));
typedef float f32x4 __attribute__((ext_vector_type(4)));
typedef float f32x16 __attribute__((ext_vector_type(16)));
typedef unsigned u32x2 __attribute__((ext_vector_type(2)));
typedef unsigned u32x4 __attribute__((ext_vector_type(4)));
typedef unsigned long long u64;

constexpr int SEQ = 4096, NB = 4, M = NB * SEQ, D = 4096, DFF = 16384, DEPTH = 2;
constexpr int NPROJ = 5376;
constexpr int C_QLAT = 0, C_KVLAT = 768, C_USSM = 1280, C_QC = 2304, C_KC = 3840, C_VC = 3968, C_QI = 4096, C_KROPE = 5120, C_KI = 5184, C_WI = 5248, NPROJ_USED = 5264;
constexpr int NQA = 2304, NKV = 3072;
constexpr float ALPHA = 1.4142135623730951f;
constexpr float LOG2E = 1.4426950408889634f;
constexpr float C2_A = 0.07216878364870322f * LOG2E;
constexpr float C2_C = 0.08838834764831845f * LOG2E;
constexpr float LN_EPS = 1e-5f, RMS_EPS = 1e-6f;

constexpr size_t MiB = 1u << 20;
constexpr size_t WS_CTL = 0, CTL_BYTES = 1 * MiB;
constexpr size_t WS_COSA = 1 * MiB, WS_SINA = WS_COSA + 512 * 1024, WS_COSI = 2 * MiB, WS_SINI = WS_COSI + 256 * 1024, WS_T5 = 2 * MiB + 512 * 1024;
constexpr size_t WS_S5P = 3 * MiB, S5P_STRIDE = 1 * MiB;
constexpr size_t S5P_A = 0, S5P_A512 = 32 * 1024, S5P_D = 64 * 1024, S5P_BB = 128 * 1024  , S5P_CM = 640 * 1024  ;
constexpr size_t WS_SS = 5 * MiB;
constexpr size_t WS_E = 7 * MiB;
constexpr size_t WS_MASK = 8 * MiB;
constexpr size_t WS_W0 = 16 * MiB, W_LSTRIDE = 340 * MiB;
constexpr size_t W_IN = 0, W_UQ = 42 * MiB, W_UKV = 46 * MiB, W_GLU = 49 * MiB, W_OUT = 51 * MiB, W_1 = 83 * MiB, W_2 = 211 * MiB;
constexpr size_t WS_HB = 696 * MiB;
constexpr size_t WS_OV = 824 * MiB;
constexpr size_t WS_FFH = WS_OV;
constexpr size_t WS_PROJ = WS_OV, WS_QA = WS_OV + 168 * MiB, WS_KV = WS_OV + 240 * MiB, WS_G = WS_OV + 336 * MiB, WS_MIX = WS_OV + 368 * MiB;
constexpr size_t WS_END = WS_OV + 512 * MiB;
static_assert(WS_W0 + 2 * W_LSTRIDE <= WS_HB && WS_MIX + (size_t)M * D * 2 <= WS_END && WS_PROJ + (size_t)M * NPROJ * 2 <= WS_QA, "ws map");
constexpr int CW_TMO = 0, CW_BAR = 4096, CW_Q = 16384;

constexpr int RING_BYTES = 131072, LDSCTL_OFF = RING_BYTES, LDS_BYTES = 147456;

#define RLX_AGENT __ATOMIC_RELAXED, __HIP_MEMORY_SCOPE_AGENT
__device__ __forceinline__ unsigned f2bf(float f) { unsigned u = __builtin_bit_cast(unsigned, f); return (u + 0x7fffu + ((u >> 16) & 1u)) >> 16; }
__device__ __forceinline__ float bf2f(unsigned h) { return __builtin_bit_cast(float, h << 16); }
typedef __bf16 bf16x2_t __attribute__((ext_vector_type(2)));
__device__ __forceinline__ unsigned cvtpk(float lo, float hi) { const f32x2 v = {lo, hi}; const bf16x2_t b = __builtin_convertvector(v, bf16x2_t); return __builtin_bit_cast(unsigned, b); }
__device__ __forceinline__ float wave_sum(float v) {
#pragma unroll
    for (int o = 1; o < 64; o <<= 1) v += __shfl_xor(v, o);
    return v;
}
namespace pg8 {
#define PG8_LAS __attribute__((address_space(3)))
typedef unsigned short bf16_t;
typedef short bf16x8 __attribute__((ext_vector_type(8)));
typedef float f32x4 __attribute__((ext_vector_type(4)));
typedef unsigned u32x4 __attribute__((ext_vector_type(4)));
constexpr int BM = 256, BK = 64, HALF = 128, HTB = HALF * BK * 2  , STAGE_BYTES = 8 * HTB, NXCD = 8, WGM = 8;

__host__ __device__ __forceinline__ int lds_byte(int r, int c) { const int st = (r >> 4) * 2 + (c >> 5), rr = r & 15, cc = c & 31, ob = rr * 64 + cc * 2; return st * 1024 + (ob ^ (((ob >> 9) & 1) << 5)); }
__host__ __device__ __forceinline__ void stage_rc(int b, int& R, int& C) { const int st = b / 1024, sb = b % 1024, swz = sb ^ (((sb >> 9) & 1) << 5); R = (st >> 1) * 16 + swz / 64; C = (st & 1) * 32 + (swz % 64) / 2; }
__host__ __device__ __forceinline__ int perm32(int rho) { const int n = rho >> 4, i = rho & 15; return 8 * (i >> 2) + 4 * n + (i & 3); }

struct Unit { int pm, pn; };
struct Gemm { const bf16_t* A; const bf16_t* Bt; int M, N, K, lda; };

struct StaticOrder {
    int nM, nN, nwg, G, c;
    __host__ __device__ void init(int M, int N, int G_, int c_) { nM = M / BM; nN = N / BM; nwg = nM * nN; G = G_; c = c_; }
    __host__ __device__ bool next(int i, Unit& u) const {
        const long L = (long)i * G + c; if (L >= nwg) return false;
        int wgid = (int)L; { const int q = nwg / NXCD, r = nwg % NXCD, xcd = wgid % NXCD, off = wgid / NXCD; wgid = (xcd < r ? xcd * (q + 1) : r * (q + 1) + (xcd - r) * q) + off; }
        const int nig = WGM * nN, gid = wgid / nig, fm = gid * WGM, gsz = (nM - fm) < WGM ? (nM - fm) : WGM;
        u.pm = fm + ((wgid % nig) % gsz); u.pn = (wgid % nig) / gsz; return true;
    }
    __device__ __forceinline__ void a_ready(const Unit&) const {}
    __device__ __forceinline__ void done(const Unit&) const {}
};
template <class Epi, class Sched, bool ALIGN_EPI = false, bool SP2 = false>
__device__ __forceinline__ void gemm_phase(PG8_LAS unsigned char* lds, const Gemm g, const Sched& S, const Epi& E) {
    int tid_ = threadIdx.x; asm volatile("" : "+v"(tid_));
    const int tid = tid_, wid = __builtin_amdgcn_readfirstlane(tid >> 6), lane = tid & 63, wr = wid >> 2, wc = wid & 3, fr = lane & 15, fq = lane >> 4;
    const int K = g.K, nt = K / BK;
    unsigned voffA[2], voffB[2];
#pragma unroll
    for (int i = 0; i < 2; ++i) { int R, C; stage_rc(tid * 16 + i * 8192, R, C); const int Rb = Epi::PERM ? ((R & ~31) + perm32(R & 31)) : R;
        voffA[i] = (unsigned)(R * g.lda + C) * 2u; voffB[i] = (unsigned)(Rb * K + C) * 2u; }
    const size_t kstep = (size_t)(BK * 2);
    const size_t hstepA = (size_t)HALF * g.lda * 2, hstepB = (size_t)HALF * K * 2;
    const size_t tstepA = 2 * hstepA, tstepB = 2 * hstepB;
    const unsigned ldsw = (unsigned)wid * 1024u;
    const int aoff = lds_byte(wr * 64 + fr, fq * 8), boff = lds_byte(wc * 32 + fr, fq * 8);
#define PG8_SA(b, h) (((b) * 2 + (h)) * HTB)
#define PG8_SB(b, h) ((4 + (b) * 2 + (h)) * HTB)
#define PG8_STAGE(bufoff, gbase, voff) do { _Pragma("unroll") for (int _i = 0; _i < 2; ++_i) \
        __builtin_amdgcn_global_load_lds((const unsigned*)((const char*)(gbase) + (voff)[_i]), (PG8_LAS unsigned*)(lds + (bufoff) + ldsw + _i * 8192), 16, 0, 0); } while (0)
#define PG8_LDA(dst, b, h) do { _Pragma("unroll") for (int m = 0; m < 4; ++m) _Pragma("unroll") for (int k = 0; k < 2; ++k) dst[m][k] = *(const PG8_LAS bf16x8*)(lds + PG8_SA(b, h) + aoff + m * 2048 + k * 1024); } while (0)
#define PG8_LDB(dst, b, h) do { _Pragma("unroll") for (int n = 0; n < 2; ++n) _Pragma("unroll") for (int k = 0; k < 2; ++k) dst[n][k] = *(const PG8_LAS bf16x8*)(lds + PG8_SB(b, h) + boff + n * 2048 + k * 1024); } while (0)
#define PG8_MMA(ai, bj, At, Bt) do { __builtin_amdgcn_s_setprio(1); _Pragma("unroll") for (int m = 0; m < 4; ++m) _Pragma("unroll") for (int n = 0; n < 2; ++n) _Pragma("unroll") for (int k = 0; k < 2; ++k) \
        acc[ai][bj][m][n] = __builtin_amdgcn_mfma_f32_16x16x32_bf16(Bt[n][k], At[m][k], acc[ai][bj][m][n], 0, 0, 0); __builtin_amdgcn_s_setprio(0); } while (0)
#define PG8_WAIT_V(n) asm volatile("s_waitcnt vmcnt(" #n ")" ::: "memory")
#define PG8_WAIT_L(n) asm volatile("s_waitcnt lgkmcnt(" #n ")" ::: "memory")
#define PG8_BAR __builtin_amdgcn_s_barrier()
#define PG8_SCHED __builtin_amdgcn_sched_barrier(0)
    Unit cur, nxt; int ui = 0;
    if (!S.next(0, cur)) return;
    f32x4 acc[2][2][4][2];
#pragma unroll
    for (int a = 0; a < 2; ++a)
#pragma unroll
        for (int b = 0; b < 2; ++b)
#pragma unroll
            for (int m = 0; m < 4; ++m)
#pragma unroll
                for (int n = 0; n < 2; ++n) acc[a][b][m][n] = (f32x4){0.f, 0.f, 0.f, 0.f};
    bf16x8 At[4][2], B0[2][2], B1[2][2];
    const char* cA = (const char*)g.A + (size_t)cur.pm * tstepA; const char* cB = (const char*)g.Bt + (size_t)cur.pn * tstepB;
    S.a_ready(cur);
    if constexpr (SP2) {
        PG8_STAGE(PG8_SB(0, 0), cB, voffB); PG8_STAGE(PG8_SB(0, 1), cB + hstepB, voffB); PG8_STAGE(PG8_SA(0, 0), cA, voffA); PG8_STAGE(PG8_SA(0, 1), cA + hstepA, voffA);
        if (wr == 1) PG8_BAR;
        PG8_WAIT_V(2); PG8_BAR;
        PG8_STAGE(PG8_SB(1, 0), cB + kstep, voffB); PG8_STAGE(PG8_SA(1, 0), cA + kstep, voffA); PG8_STAGE(PG8_SB(1, 1), cB + hstepB + kstep, voffB);
        PG8_WAIT_V(6); PG8_BAR;
    } else {
        PG8_STAGE(PG8_SB(0, 0), cB, voffB); PG8_STAGE(PG8_SA(0, 0), cA, voffA); PG8_STAGE(PG8_SB(0, 1), cB + hstepB, voffB); PG8_STAGE(PG8_SA(0, 1), cA + hstepA, voffA);
        if (wr == 1) PG8_BAR;
        PG8_WAIT_V(4); PG8_BAR;
        PG8_STAGE(PG8_SB(1, 0), cB + kstep, voffB); PG8_STAGE(PG8_SA(1, 0), cA + kstep, voffA); PG8_STAGE(PG8_SB(1, 1), cB + hstepB + kstep, voffB);
        PG8_WAIT_V(6); PG8_BAR;
    }
    for (;;) {
        const bool has_next = S.next(ui + 1, nxt);
        const char* nA = has_next ? (const char*)g.A + (size_t)nxt.pm * tstepA : cA; const char* nB = has_next ? (const char*)g.Bt + (size_t)nxt.pn * tstepB : cB;
        for (int t = 0; t < nt; t += 2) {
            const bool last = (t == nt - 2);
            const char* a1 = cA + (size_t)(t + 1) * kstep;
            const char* a2 = last ? nA : cA + (size_t)(t + 2) * kstep; const char* b2 = last ? nB : cB + (size_t)(t + 2) * kstep;
            const char* a3 = a2 + kstep; const char* b3 = b2 + kstep;
            if (last && has_next) S.a_ready(nxt);
            if constexpr (SP2) {
            PG8_LDB(B0, 0, 0); PG8_LDB(B1, 0, 1); PG8_SCHED; PG8_LDA(At, 0, 0); PG8_STAGE(PG8_SA(1, 1), a1 + hstepA, voffA);
            PG8_WAIT_V(8); PG8_WAIT_L(0); PG8_BAR; PG8_MMA(0, 0, At, B0); PG8_MMA(0, 1, At, B1); PG8_BAR; PG8_SCHED;
            PG8_LDA(At, 0, 1); PG8_STAGE(PG8_SB(0, 0), b2, voffB); PG8_STAGE(PG8_SB(0, 1), b2 + hstepB, voffB); PG8_STAGE(PG8_SA(0, 0), a2, voffA);
            PG8_WAIT_V(8); PG8_WAIT_L(0); PG8_BAR; PG8_MMA(1, 0, At, B0); PG8_MMA(1, 1, At, B1); PG8_BAR; PG8_SCHED;
            PG8_LDB(B0, 1, 0); PG8_LDB(B1, 1, 1); PG8_SCHED; PG8_LDA(At, 1, 0); PG8_STAGE(PG8_SA(0, 1), a2 + hstepA, voffA);
            PG8_WAIT_V(8); PG8_WAIT_L(0); PG8_BAR; PG8_MMA(0, 0, At, B0); PG8_MMA(0, 1, At, B1); PG8_BAR; PG8_SCHED;
            PG8_LDA(At, 1, 1); PG8_STAGE(PG8_SB(1, 0), b3, voffB); PG8_STAGE(PG8_SB(1, 1), b3 + hstepB, voffB); PG8_STAGE(PG8_SA(1, 0), a3, voffA);
            PG8_WAIT_V(8); PG8_WAIT_L(0); PG8_BAR; PG8_MMA(1, 0, At, B0); PG8_MMA(1, 1, At, B1); PG8_BAR; PG8_SCHED;
            } else {
            PG8_LDB(B0, 0, 0); PG8_SCHED; PG8_LDA(At, 0, 0); PG8_STAGE(PG8_SA(1, 1), a1 + hstepA, voffA);
            PG8_WAIT_L(8); PG8_BAR; PG8_WAIT_L(0); PG8_MMA(0, 0, At, B0); PG8_BAR; PG8_SCHED;
            PG8_LDB(B1, 0, 1); PG8_STAGE(PG8_SB(0, 0), b2, voffB);
            PG8_BAR; PG8_WAIT_L(0); PG8_MMA(0, 1, At, B1); PG8_BAR;
            PG8_LDA(At, 0, 1); PG8_STAGE(PG8_SA(0, 0), a2, voffA);
            PG8_BAR; PG8_WAIT_L(0); PG8_MMA(1, 0, At, B0); PG8_BAR; PG8_SCHED;
            PG8_STAGE(PG8_SB(0, 1), b2 + hstepB, voffB);
            PG8_WAIT_V(6); PG8_BAR; PG8_MMA(1, 1, At, B1); PG8_BAR;
            PG8_LDB(B0, 1, 0); PG8_SCHED; PG8_LDA(At, 1, 0); PG8_STAGE(PG8_SA(0, 1), a2 + hstepA, voffA);
            PG8_WAIT_L(8); PG8_BAR; PG8_WAIT_L(0); PG8_MMA(0, 0, At, B0); PG8_BAR; PG8_SCHED;
            PG8_LDB(B1, 1, 1); PG8_STAGE(PG8_SB(1, 0), b3, voffB);
            PG8_BAR; PG8_WAIT_L(0); PG8_MMA(0, 1, At, B1); PG8_BAR;
            PG8_LDA(At, 1, 1); PG8_STAGE(PG8_SA(1, 0), a3, voffA);
            PG8_BAR; PG8_WAIT_L(0); PG8_MMA(1, 0, At, B0); PG8_BAR; PG8_SCHED;
            PG8_STAGE(PG8_SB(1, 1), b3 + hstepB, voffB);
            PG8_WAIT_V(6); PG8_BAR; PG8_MMA(1, 1, At, B1); PG8_BAR;
            }
        }
        if constexpr (ALIGN_EPI) { if (wr == 0) PG8_BAR; }
        if constexpr (!Epi::AFTER_DRAIN) { E(acc, cur, wr, wc, fr, fq); S.done(cur); }
        if (!has_next) break;
#pragma unroll
        for (int a = 0; a < 2; ++a)
#pragma unroll
            for (int b = 0; b < 2; ++b)
#pragma unroll
                for (int m = 0; m < 4; ++m)
#pragma unroll
                    for (int n = 0; n < 2; ++n) acc[a][b][m][n] = (f32x4){0.f, 0.f, 0.f, 0.f};
        cur = nxt; cA = nA; cB = nB; ++ui;
        if constexpr (ALIGN_EPI) { if (wr == 1) PG8_BAR; }
    }
    PG8_WAIT_V(0);
    if constexpr (!ALIGN_EPI) { if (wr == 0) PG8_BAR; }
    PG8_BAR;
    if constexpr (Epi::AFTER_DRAIN) { E.fused(acc, cur, wr, wc, fr, fq, lds, wid, lane); S.done(cur); }
#undef PG8_SA
#undef PG8_SB
#undef PG8_STAGE
#undef PG8_LDA
#undef PG8_LDB
#undef PG8_MMA
#undef PG8_WAIT_V
#undef PG8_WAIT_L
#undef PG8_BAR
#undef PG8_SCHED
}
}
namespace pg8 {
struct EpiProj {
    static constexpr bool PERM = true, AFTER_DRAIN = false;
    bf16_t* O; float* ss; const float* cosA; const float* sinA; const float* cosI; const float* sinI;
    __device__ __forceinline__ void operator()(const f32x4 (&acc)[2][2][4][2], const Unit& u, int wr, int wc, int fr, int fq) const {
        const int row0 = u.pm * BM + wr * 64 + fr, pn = u.pn, col0 = pn * BM + wc * 32 + 8 * fq;
        int mode[2], f0[2];
#pragma unroll
        for (int bj = 0; bj < 2; ++bj) {
            int md = 0, f = 0;
            if (pn >= 9 && pn <= 14) md = 1;
            else if (pn >= 16 && pn <= 19) { if ((wc & 1) == 0) { md = 3; f = 4 * fq; } }
            else if (pn == 20 && bj == 0) { if (wc < 2) { md = 2; f = 16 * wc + 4 * fq; } else if (wc == 2) { md = 3; f = 4 * fq; } }
            mode[bj] = md; f0[bj] = f;
        }
#pragma unroll
        for (int ai = 0; ai < 2; ++ai)
#pragma unroll
            for (int m = 0; m < 4; ++m) {
                const int row = row0 + ai * HALF + m * 16, t = row & (SEQ - 1);
                bf16_t* rowp = O + (size_t)row * NPROJ + col0; float sq = 0.f;
#pragma unroll
                for (int bj = 0; bj < 2; ++bj) {
                    f32x4 v0 = acc[ai][bj][m][0], v1 = acc[ai][bj][m][1];
                    if (mode[bj] == 1) { v0 = v0 * C2_C; v1 = v1 * C2_C; }
                    else if (mode[bj] >= 2) {
                        const float* ct = mode[bj] == 2 ? cosA + t * 32 : cosI + t * 16; const float* st = mode[bj] == 2 ? sinA + t * 32 : sinI + t * 16;
                        const f32x4 c = *(const f32x4*)(ct + f0[bj]), s = *(const f32x4*)(st + f0[bj]);
                        const f32x4 o0 = v0 * c - v1 * s, o1 = v1 * c + v0 * s; v0 = o0; v1 = o1;
                    }
                    u32x4 w; w.x = cvtpk(v0[0], v0[1]); w.y = cvtpk(v0[2], v0[3]); w.z = cvtpk(v1[0], v1[1]); w.w = cvtpk(v1[2], v1[3]);
                    *(u32x4*)(rowp + bj * HALF) = w;
                    if (pn < 5) {
#pragma unroll
                        for (int e = 0; e < 4; ++e) { const float lo = bf2f(w[e] & 0xffffu), hi = bf2f(w[e] >> 16); sq += lo * lo + hi * hi; }
                    }
                }
                if (pn < 5) { sq += __shfl_xor(sq, 16); sq += __shfl_xor(sq, 32); if (fq == 0) ss[(size_t)(pn * 4 + wc) * M + row] = sq; }
            }
    }
};
template <bool QUP> struct EpiUp {
    static constexpr bool PERM = true, AFTER_DRAIN = false;
    bf16_t* O; const float* ss; const float* cosA; const float* sinA;
    __device__ __forceinline__ void operator()(const f32x4 (&acc)[2][2][4][2], const Unit& u, int wr, int wc, int fr, int fq) const {
        constexpr int ldc = QUP ? NQA : NKV, s0 = QUP ? 0 : 12, ns = QUP ? 12 : 8; constexpr float inv = QUP ? 1.f / 768.f : 1.f / 512.f, sc = QUP ? C2_A : 1.f;
        const int row0 = u.pm * BM + wr * 64 + fr, col0 = u.pn * BM + wc * 32 + 8 * fq;
        const bool rope = QUP && u.pn >= 6; const int f0 = 16 * (wc & 1) + 4 * fq;
#pragma unroll
        for (int ai = 0; ai < 2; ++ai)
#pragma unroll
            for (int m = 0; m < 4; ++m) {
                const int row = row0 + ai * HALF + m * 16, t = row & (SEQ - 1);
                float s = 0.f;
#pragma unroll
                for (int k = 0; k < ns / 4; ++k) s += ss[(size_t)(s0 + fq * (ns / 4) + k) * M + row];
                s += __shfl_xor(s, 16); s += __shfl_xor(s, 32);
                const float rs = sc / sqrtf(s * inv + RMS_EPS);
                bf16_t* rowp = O + (size_t)row * ldc + col0;
#pragma unroll
                for (int bj = 0; bj < 2; ++bj) {
                    f32x4 v0 = acc[ai][bj][m][0] * rs, v1 = acc[ai][bj][m][1] * rs;
                    if (rope) { const f32x4 c = *(const f32x4*)(cosA + t * 32 + f0), sn = *(const f32x4*)(sinA + t * 32 + f0);
                        const f32x4 o0 = v0 * c - v1 * sn, o1 = v1 * c + v0 * sn; v0 = o0; v1 = o1; }
                    u32x4 w; w.x = cvtpk(v0[0], v0[1]); w.y = cvtpk(v0[2], v0[3]); w.z = cvtpk(v1[0], v1[1]); w.w = cvtpk(v1[2], v1[3]);
                    *(u32x4*)(rowp + bj * HALF) = w;
                }
            }
    }
};
struct EpiGlu {
    static constexpr bool PERM = true, AFTER_DRAIN = false;
    bf16_t* O; const bf16_t* G; const float* bias;
    __device__ __forceinline__ void operator()(const f32x4 (&acc)[2][2][4][2], const Unit& u, int wr, int wc, int fr, int fq) const {
        const int row0 = u.pm * BM + wr * 64 + fr, col0 = u.pn * BM + wc * 32 + 8 * fq;
        f32x4 bv[2][2];
#pragma unroll
        for (int bj = 0; bj < 2; ++bj)
#pragma unroll
            for (int n = 0; n < 2; ++n) bv[bj][n] = *(const f32x4*)(bias + col0 + bj * HALF + 4 * n);
#pragma unroll
        for (int ai = 0; ai < 2; ++ai)
#pragma unroll
            for (int m = 0; m < 4; ++m) {
                const int row = row0 + ai * HALF + m * 16;
#pragma unroll
                for (int bj = 0; bj < 2; ++bj) {
                    const u32x4 gw = *(const u32x4*)(G + (size_t)row * 1024 + col0 + bj * HALF);
                    float o[8];
#pragma unroll
                    for (int e = 0; e < 8; ++e) { const float z = acc[ai][bj][m][e >> 2][e & 3] + bv[bj][e >> 2][e & 3];
                        const float gg = (e & 1) ? bf2f(gw[e >> 1] >> 16) : bf2f(gw[e >> 1] & 0xffffu);
                        o[e] = gg / (1.f + __expf(-z)); }
                    u32x4 w; w.x = cvtpk(o[0], o[1]); w.y = cvtpk(o[2], o[3]); w.z = cvtpk(o[4], o[5]); w.w = cvtpk(o[6], o[7]);
                    *(u32x4*)(O + (size_t)row * D + 1536 + col0 + bj * HALF) = w;
                }
            }
    }
};
struct EpiRes {
    static constexpr bool PERM = true, AFTER_DRAIN = false;
    bf16_t* H;
    __device__ __forceinline__ void operator()(const f32x4 (&acc)[2][2][4][2], const Unit& u, int wr, int wc, int fr, int fq) const {
        const int row0 = u.pm * BM + wr * 64 + fr, col0 = u.pn * BM + wc * 32 + 8 * fq;
#pragma unroll
        for (int ai = 0; ai < 2; ++ai)
#pragma unroll
            for (int m = 0; m < 4; ++m) { bf16_t* rowp = H + (size_t)(row0 + ai * HALF + m * 16) * D + col0;
                u32x4 hv[2];
#pragma unroll
                for (int bj = 0; bj < 2; ++bj) hv[bj] = *(const u32x4*)(rowp + bj * HALF);
#pragma unroll
                for (int bj = 0; bj < 2; ++bj) { float o[8];
#pragma unroll
                    for (int e = 0; e < 8; ++e) { const float hh = (e & 1) ? bf2f(hv[bj][e >> 1] >> 16) : bf2f(hv[bj][e >> 1] & 0xffffu); o[e] = __builtin_fmaf(hh, ALPHA, acc[ai][bj][m][e >> 2][e & 3]); }
                    u32x4 w; w.x = cvtpk(o[0], o[1]); w.y = cvtpk(o[2], o[3]); w.z = cvtpk(o[4], o[5]); w.w = cvtpk(o[6], o[7]);
                    *(u32x4*)(rowp + bj * HALF) = w; } }
    }
};
struct EpiRelu2 {
    static constexpr bool PERM = true, AFTER_DRAIN = false;
    bf16_t* O;
    __device__ __forceinline__ void operator()(const f32x4 (&acc)[2][2][4][2], const Unit& u, int wr, int wc, int fr, int fq) const {
        const int row0 = u.pm * BM + wr * 64 + fr, col0 = u.pn * BM + wc * 32 + 8 * fq;
#pragma unroll
        for (int ai = 0; ai < 2; ++ai)
#pragma unroll
            for (int m = 0; m < 4; ++m) { bf16_t* rowp = O + (size_t)(row0 + ai * HALF + m * 16) * DFF + col0;
#pragma unroll
                for (int bj = 0; bj < 2; ++bj) { f32x4 v0 = acc[ai][bj][m][0], v1 = acc[ai][bj][m][1];
#pragma unroll
                    for (int e = 0; e < 4; ++e) { const float a = fmaxf(v0[e], 0.f), b = fmaxf(v1[e], 0.f); v0[e] = a * a; v1[e] = b * b; }
                    u32x4 w; w.x = cvtpk(v0[0], v0[1]); w.y = cvtpk(v0[2], v0[3]); w.z = cvtpk(v1[0], v1[1]); w.w = cvtpk(v1[2], v1[3]);
                    *(u32x4*)(rowp + bj * HALF) = w; } }
    }
};
}
#define XB_TMO      128
#define XB_XCNT(j)  (256  + 64 * (j))
#define XB_XSUB(j)  (1280 + 64 * (j))
#define XB_XGEN(j)  (2304 + 64 * (j))
#define XB_TOP      3328
#define XB_TOPGEN   3392
#define XCD_BAR_WORDS 3456
#define XB_SPIN_CAP (1u << 18)

__device__ __forceinline__ unsigned xb_ld(unsigned* p)              { return __hip_atomic_load(p, __ATOMIC_RELAXED, __HIP_MEMORY_SCOPE_AGENT); }
__device__ __forceinline__ unsigned xb_add(unsigned* p, unsigned v) { return __hip_atomic_fetch_add(p, v, __ATOMIC_RELAXED, __HIP_MEMORY_SCOPE_AGENT); }
__device__ __forceinline__ unsigned xb_xcc_id() { return (unsigned)__builtin_amdgcn_s_getreg((3 << 11) | 20) & 0xFu; }
#define XB_SPIN(cond, bar) do { unsigned _sp = 0; while (cond) { __builtin_amdgcn_s_sleep(1); \
    if ((++_sp & 255u) == 0u) { if (xb_ld(&(bar)[XB_TMO])) break; if (_sp > XB_SPIN_CAP) { atomicAdd(&(bar)[XB_TMO], 1u); break; } } } } while (0)

struct XcdBarrier {
    unsigned* bar; unsigned x;
    volatile LAS unsigned* st;
};

__device__ __forceinline__ XcdBarrier xcd_barrier_post(unsigned* bar, volatile LAS unsigned* st) {
    XcdBarrier b; b.bar = bar; b.x = xb_xcc_id(); b.st = st;
    if (threadIdx.x == 0) (void)xb_add(&bar[XB_XCNT(b.x)], 1u);
    return b;
}
__device__ __forceinline__ void xcd_barrier_complete(unsigned* bar, unsigned x, unsigned& nloc, unsigned& nx) {
    const unsigned G = gridDim.x * gridDim.y * gridDim.z;
    unsigned sum, cnt, mine, sp = 0u;
    for (;;) {
        sum = 0u; cnt = 0u; mine = 0u;
#pragma unroll
        for (unsigned j = 0; j < 16; ++j) { const unsigned c = xb_ld(&bar[XB_XCNT(j)]); sum += c; cnt += (c > 0u) ? 1u : 0u; mine = (j == x) ? c : mine; }
        if (sum == G) break;
        __builtin_amdgcn_s_sleep(1);
        if ((++sp & 255u) == 0u) { if (xb_ld(&bar[XB_TMO])) break; if (sp > XB_SPIN_CAP) { atomicAdd(&bar[XB_TMO], 1u); break; } }
    }
    nloc = mine > 0u ? mine : 1u; nx = cnt > 0u ? cnt : 1u;
}

__device__ __forceinline__ void xcd_barrier(const XcdBarrier& b) {
    asm volatile("s_waitcnt vmcnt(0)" ::: "memory");
    __syncthreads();
    if (threadIdx.x == 0) {
        unsigned* bar = b.bar;
        __builtin_amdgcn_s_waitcnt(0);
        unsigned nloc = b.st[0], nx = b.st[1];
        if (nloc == 0u) { xcd_barrier_complete(bar, b.x, nloc, nx); b.st[0] = nloc; b.st[1] = nx; }
        const unsigned old = xb_add(&bar[XB_XSUB(b.x)], 1u);
        const unsigned gen = old / nloc;
        if (old + 1u == (gen + 1u) * nloc) {
            __builtin_amdgcn_fence(__ATOMIC_RELEASE, "agent");
            asm volatile("s_waitcnt vmcnt(0)" ::: "memory");
            const unsigned og = xb_add(&bar[XB_TOP], 1u);
            const unsigned tg = og / nx;
            if (og + 1u == (tg + 1u) * nx) xb_add(&bar[XB_TOPGEN], 1u);
            else XB_SPIN(xb_ld(&bar[XB_TOPGEN]) == tg, bar);
            __builtin_amdgcn_fence(__ATOMIC_ACQUIRE, "agent");
            xb_add(&bar[XB_XGEN(b.x)], 1u);
            asm volatile("s_waitcnt vmcnt(0)" ::: "memory");
        } else {
            XB_SPIN(xb_ld(&bar[XB_XGEN(b.x)]) == gen, bar);
            __builtin_amdgcn_fence(__ATOMIC_ACQUIRE, "agent");
            asm volatile("s_waitcnt vmcnt(0)" ::: "memory");
        }
    }
    __syncthreads();
}

struct Frame {
    LAS unsigned char* lds;
    int tid, lane, wave, vcu, G;
};
#define CAS __attribute__((address_space(4)))
__device__ __forceinline__ const CAS char* karg_base() { const CAS char* p = (const CAS char*)__builtin_amdgcn_kernarg_segment_ptr(); asm volatile("" : "+s"(p)); return p; }
__device__ __forceinline__ const float* inp(int i) { return *(const float* const CAS*)(karg_base() + 8 * i); }
__device__ __forceinline__ float* x_base() { return *(float* const CAS*)(karg_base() + 208); }
__device__ __forceinline__ unsigned char* ws_base() { return *(unsigned char* const CAS*)(karg_base() + 216); }
__device__ __forceinline__ unsigned* ctl_base() { return (unsigned*)(ws_base() + WS_CTL); }
enum { I_X = 0, I_LNG, I_LNB, I_RELB, I_WIN, I_AGQ, I_AWUQ, I_AGKV, I_AWUKV, I_LRE, I_LIM, I_LSTEP, I_BRE, I_BIM, I_CRE, I_CIM, I_SD, I_WGLU, I_BGLU, I_WOUT, I_LN1G, I_LN1B, I_WFF1, I_WFF2, I_LN2G, I_LN2B };

__device__ __forceinline__ void dsincos(double x, double& s, double& c) {
    const double kq = rint(x * 0.6366197723675814);
    double r = fma(-kq, 1.5707963267948966, x); r = fma(-kq, 6.123233995736766e-17, r);
    const int q = (int)((long long)kq & 3);
    const double r2 = r * r;
    const double sp = r * (1.0 + r2 * (-1.0 / 6.0 + r2 * (1.0 / 120.0 + r2 * (-1.0 / 5040.0 + r2 * (1.0 / 362880.0 + r2 * (-1.0 / 39916800.0 + r2 * (1.0 / 6227020800.0 + r2 * (-1.0 / 1307674368000.0))))))));
    const double cp = 1.0 + r2 * (-0.5 + r2 * (1.0 / 24.0 + r2 * (-1.0 / 720.0 + r2 * (1.0 / 40320.0 + r2 * (-1.0 / 3628800.0 + r2 * (1.0 / 479001600.0 + r2 * (-1.0 / 87178291200.0 + r2 * (1.0 / 20922789888000.0))))))));
    s = (q == 0) ? sp : (q == 1) ? cp : (q == 2) ? -sp : -cp;
    c = (q == 0) ? cp : (q == 1) ? -sp : (q == 2) ? -cp : sp;
}
__device__ __forceinline__ void s5_coef(const Frame& F, int l, int g, int n, double& ar, double& ai, double& cr, double& ci) {
    const double lr = (double)inp(I_LRE)[(l * 64 + g) * 64 + n], li = (double)inp(I_LIM)[(l * 64 + g) * 64 + n];
    const double dt = exp((double)inp(I_LSTEP)[l * 64 + g]);
    const double mag = exp(lr * dt); double s, c; dsincos(fabs(li * dt), s, c); if (li * dt < 0.0) s = -s;
    ar = mag * c; ai = mag * s;
    const double den = lr * lr + li * li, nr = ar - 1.0, ni = ai;
    cr = (nr * lr + ni * li) / den; ci = (ni * lr - nr * li) / den;
}
__device__ __forceinline__ int il32(int d) { return d < 16 ? 8 * (d >> 2) + (d & 3) : 8 * ((d - 16) >> 2) + 4 + (d & 3); }
__device__ __forceinline__ int il64(int d) { return d < 32 ? 8 * (d >> 2) + (d & 3) : 8 * ((d - 32) >> 2) + 4 + (d & 3); }
__device__ __forceinline__ int phys_win(int n) {
    if (n < 1280) return n;
    if (n < 1344) return C_KROPE + il64(n - 1280);
    if (n < 2368) return C_USSM + (n - 1344);
    if (n < 3904) return C_QC + (n - 2368);
    if (n < 4160) return C_KC + (n - 3904);
    if (n < 5184) { const int j = n - 4160, d = j & 63; return C_QI + (j & ~63) + (d < 32 ? il32(d) : d); }
    if (n < 5248) { const int d = n - 5184; return C_KI + (d < 32 ? il32(d) : d); }
    return C_WI + (n - 5248);
}
__device__ __forceinline__ int phys_uq(int n) { const int h = n / 192, o = n - h * 192; return o < 128 ? h * 128 + o : 1536 + h * 64 + il64(o - 128); }
template <int PM  >
__device__ __forceinline__ void cvt_item(const float* W, int K, int N, bf16* WT, const float* gk, LAS float* scr, int item, int lane) {
    const int nblk = (N + 31) / 32, kb = item / nblk, nb = item - kb * nblk, k0 = 64 * kb, n0 = 32 * nb;
    const int rr = lane >> 3, n4 = (lane & 7) * 4;
#pragma unroll
    for (int i = 0; i < 8; ++i) { const int row = i * 8 + rr;
        f32x4 v = (f32x4){0.f, 0.f, 0.f, 0.f}; if (n0 + n4 < N) v = *(const f32x4*)(W + (size_t)(k0 + row) * N + n0 + n4);
        LAS float* d = scr + row * 33 + n4; d[0] = v.x; d[1] = v.y; d[2] = v.z; d[3] = v.w; }
    asm volatile("s_waitcnt lgkmcnt(0)" ::: "memory");
    const int c = lane & 7;
    float gs[8];
#pragma unroll
    for (int j = 0; j < 8; ++j) gs[j] = gk ? gk[k0 + 8 * c + j] : 1.f;
#pragma unroll
    for (int j = 0; j < 4; ++j) { const int n = (lane >> 3) + 8 * j; const LAS float* s = scr + (8 * c) * 33 + n;
        if (n0 + n < N) { const int pr = PM == 1 ? phys_win(n0 + n) : PM == 2 ? phys_uq(n0 + n) : n0 + n;
            u32x4 o; o.x = f2bf(s[0] * gs[0]) | (f2bf(s[33] * gs[1]) << 16); o.y = f2bf(s[66] * gs[2]) | (f2bf(s[99] * gs[3]) << 16);
            o.z = f2bf(s[132] * gs[4]) | (f2bf(s[165] * gs[5]) << 16); o.w = f2bf(s[198] * gs[6]) | (f2bf(s[231] * gs[7]) << 16);
            *(u32x4*)(WT + (size_t)pr * K + k0 + 8 * c) = o; } }
    asm volatile("s_waitcnt lgkmcnt(0)" ::: "memory");
}
template <bool IN_F32>
__device__ __forceinline__ void ln_load(const float* xrow, const bf16* hrow, f32x4 (&v)[16], int lane) {
    if (IN_F32) {
#pragma unroll
        for (int j = 0; j < 16; ++j) v[j] = *(const f32x4*)(xrow + 4 * lane + 256 * j);
    } else {
#pragma unroll
        for (int j = 0; j < 8; ++j) { const u32x4 w = *(const u32x4*)(hrow + 8 * lane + 512 * j);
            v[2 * j] = (f32x4){bf2f(w.x & 0xffffu), bf2f(w.x >> 16), bf2f(w.y & 0xffffu), bf2f(w.y >> 16)}; v[2 * j + 1] = (f32x4){bf2f(w.z & 0xffffu), bf2f(w.z >> 16), bf2f(w.w & 0xffffu), bf2f(w.w >> 16)}; }
    }
}
template <bool IN_F32, bool OUT_F32>
__device__ __forceinline__ void ln_finish(f32x4 (&v)[16], const float* g, const float* b, float* orow, bf16* hrow, int lane) {
    float s = 0.f;
#pragma unroll
    for (int j = 0; j < 16; ++j) s += (v[j].x + v[j].y) + (v[j].z + v[j].w);
    const float mean = wave_sum(s) * (1.f / D); float s2 = 0.f;
#pragma unroll
    for (int j = 0; j < 16; ++j) { v[j] = v[j] - mean; s2 += (v[j].x * v[j].x + v[j].y * v[j].y) + (v[j].z * v[j].z + v[j].w * v[j].w); }
    const float rstd = 1.f / sqrtf(wave_sum(s2) * (1.f / D) + LN_EPS);
    if (IN_F32) {
#pragma unroll
        for (int j = 0; j < 16; ++j) { const int c = 4 * lane + 256 * j; const f32x4 gg = *(const f32x4*)(g + c), bb = *(const f32x4*)(b + c);
            const f32x4 y = v[j] * rstd * gg + bb; if (OUT_F32) *(f32x4*)(orow + c) = y;
            u32x2 w; w.x = cvtpk(y.x, y.y); w.y = cvtpk(y.z, y.w); *(u32x2*)(hrow + c) = w; }
    } else {
#pragma unroll
        for (int j = 0; j < 8; ++j) { const int c = 8 * lane + 512 * j;
            const f32x4 g0 = *(const f32x4*)(g + c), g1 = *(const f32x4*)(g + c + 4), b0 = *(const f32x4*)(b + c), b1 = *(const f32x4*)(b + c + 4);
            const f32x4 y0 = v[2 * j] * rstd * g0 + b0, y1 = v[2 * j + 1] * rstd * g1 + b1;
            if (OUT_F32) { *(f32x4*)(orow + c) = y0; *(f32x4*)(orow + c + 4) = y1; }
            else { u32x4 w; w.x = cvtpk(y0.x, y0.y); w.y = cvtpk(y0.z, y0.w); w.z = cvtpk(y1.x, y1.y); w.w = cvtpk(y1.z, y1.w); *(u32x4*)(hrow + c) = w; } }
    }
}
template <bool IN_F32, bool OUT_F32>
__device__ __forceinline__ void ln_phase(Frame& F, const float* src, const float* g, const float* b) {
    const int gw = F.vcu * 8 + F.wave, NGW = F.G * 8; bf16* HB = (bf16*)(ws_base() + WS_HB); float* X = x_base();
    int m = gw;
    if (!IN_F32) for (; m + NGW < M; m += 2 * NGW) { const int m2 = m + NGW; f32x4 va[16], vb[16];
        ln_load<IN_F32>(src + (size_t)m * D, HB + (size_t)m * D, va, F.lane); ln_load<IN_F32>(src + (size_t)m2 * D, HB + (size_t)m2 * D, vb, F.lane);
        ln_finish<IN_F32, OUT_F32>(va, g, b, X + (size_t)m * D, HB + (size_t)m * D, F.lane); ln_finish<IN_F32, OUT_F32>(vb, g, b, X + (size_t)m2 * D, HB + (size_t)m2 * D, F.lane); }
    for (; m < M; m += NGW) { f32x4 va[16]; ln_load<IN_F32>(src + (size_t)m * D, HB + (size_t)m * D, va, F.lane); ln_finish<IN_F32, OUT_F32>(va, g, b, X + (size_t)m * D, HB + (size_t)m * D, F.lane); }
}
template <int PSEL> __device__ __forceinline__ void p0_prologue(Frame& F, unsigned long long& pacc) {
    unsigned long long pt0_ = 0ull; if (PSEL) pt0_ = __builtin_amdgcn_s_memrealtime();
    const int gw = F.vcu * 8 + F.wave, NGW = F.G * 8, gt = gw * 64 + F.lane, NGT = NGW * 64;
    unsigned char* ws = ws_base();
    for (int i = gt; i < SEQ * 48; i += NGT) {
        const bool isA = i < SEQ * 32; const int j = isA ? i : i - SEQ * 32, nf = isA ? 32 : 16, t = j / nf, f = j - t * nf;
        const double inv = exp(-((double)f / (double)nf) * 9.210340371976184); double s, c; dsincos((double)t * inv, s, c);
        if (isA) { ((float*)(ws + WS_COSA))[j] = (float)c; ((float*)(ws + WS_SINA))[j] = (float)s; } else { ((float*)(ws + WS_COSI))[j] = (float)c; ((float*)(ws + WS_SINI))[j] = (float)s; }
    }
    for (int i = gt; i < 12 * 192; i += NGT) {
        const int h = i / 192, rel = (i - h * 192) - 128, n = rel < 0 ? -rel : rel; int bk = rel > 0 ? 16 : 0;
        if (n < 8) bk += n; else { int lg = 8 + (int)(logf((float)n / 8.f) / 2.772588722239781f * 8.f); if (lg > 15) lg = 15; bk += lg; }
        ((float*)(ws + WS_T5))[i] = inp(I_RELB)[bk * 12 + h] * LOG2E;
    }
    for (int i = gt; i < DEPTH * 4096; i += NGT) {
        const int l = i >> 12, g = (i >> 6) & 63, n = i & 63; double ar, ai, cr, ci; s5_coef(F, l, g, n, ar, ai, cr, ci);
        float* pa = (float*)(ws + WS_S5P + l * S5P_STRIDE + S5P_A) + (g * 64 + n) * 2; pa[0] = (float)ar; pa[1] = (float)ai;
        double pr = ar, pi = ai;
#pragma unroll 1
        for (int k = 0; k < 9; ++k) { const double tr = pr * pr - pi * pi, ti = 2.0 * pr * pi; pr = tr; pi = ti; }
        float* pb = (float*)(ws + WS_S5P + l * S5P_STRIDE + S5P_A512) + (g * 64 + n) * 2; pb[0] = (float)pr; pb[1] = (float)pi;
    }
    for (int i = gt; i < DEPTH * 64 * 8 * 64; i += NGT) {
        const int l = i >> 15, g = (i >> 9) & 63, ct = (i >> 6) & 7, ln = i & 63, oc = ct * 16 + (ln & 15), n = oc & 63, kq = ln >> 4;
        u32x4 o = (u32x4){0u, 0u, 0u, 0u};
        if (kq < 2) { double ar, ai, cr, ci; s5_coef(F, l, g, n, ar, ai, cr, ci); unsigned hv[8];
#pragma unroll
            for (int j = 0; j < 8; ++j) { const int p = 8 * kq + j; const size_t bi = ((size_t)(l * 64 + g) * 64 + n) * 16 + p; const double br = inp(I_BRE)[bi], bim = inp(I_BIM)[bi];
                hv[j] = f2bf((float)(oc < 64 ? cr * br - ci * bim : cr * bim + ci * br)); }
            o.x = hv[0] | (hv[1] << 16); o.y = hv[2] | (hv[3] << 16); o.z = hv[4] | (hv[5] << 16); o.w = hv[6] | (hv[7] << 16); }
        *(u32x4*)(ws + WS_S5P + l * S5P_STRIDE + S5P_BB + ((size_t)(g * 8 + ct) * 64 + ln) * 16) = o;
    }
    for (int i = gt; i < DEPTH * 64 * 4 * 64; i += NGT) {
        const int l = i >> 14, g = (i >> 8) & 63, ks = (i >> 6) & 3, ln = i & 63, p = ln & 15; unsigned hv[8];
#pragma unroll
        for (int j = 0; j < 8; ++j) { const int k = 32 * ks + 8 * (ln >> 4) + j; const size_t ci_ = ((size_t)(l * 64 + g) * 16 + p) * 64 + (k & 63);
            hv[j] = f2bf(k < 64 ? inp(I_CRE)[ci_] : -inp(I_CIM)[ci_]); }
        u32x4 o; o.x = hv[0] | (hv[1] << 16); o.y = hv[2] | (hv[3] << 16); o.z = hv[4] | (hv[5] << 16); o.w = hv[6] | (hv[7] << 16);
        *(u32x4*)(ws + WS_S5P + l * S5P_STRIDE + S5P_CM + ((size_t)(g * 4 + ks) * 64 + ln) * 16) = o;
    }
    for (int i = gt; i < DEPTH * 112 * 512; i += NGT) { const int l = i / (112 * 512), r = i - l * 112 * 512;
        *(u32x4*)(ws + WS_W0 + l * W_LSTRIDE + W_IN + (size_t)NPROJ_USED * D * 2 + (size_t)r * 16) = (u32x4){0u, 0u, 0u, 0u}; }
    if (PSEL == 1) pacc += __builtin_amdgcn_s_memrealtime() - pt0_;
    if (PSEL == 2) pt0_ = __builtin_amdgcn_s_memrealtime();
    LAS float* scr = (LAS float*)(F.lds + F.wave * 16384);
    constexpr int IT_IN = (D / 64) * ((NPROJ_USED + 31) / 32), IT_UQ = (768 / 64) * (2304 / 32), IT_UKV = (512 / 64) * (3072 / 32), IT_GLU = (1024 / 64) * (1024 / 32),
                  IT_OUT = (D / 64) * (D / 32), IT_1 = (D / 64) * (DFF / 32), IT_2 = (DFF / 64) * (D / 32), IT_L = IT_IN + IT_UQ + IT_UKV + IT_GLU + IT_OUT + IT_1 + IT_2;
    for (int it = gw; it < DEPTH * IT_L; it += NGW) {
        const int l = it / IT_L; int r = it - l * IT_L; unsigned char* wl = ws + WS_W0 + l * W_LSTRIDE;
        if (r < IT_IN) { cvt_item<1>(inp(I_WIN) + (size_t)l * D * NPROJ_USED, D, NPROJ_USED, (bf16*)(wl + W_IN), nullptr, scr, r, F.lane); continue; } r -= IT_IN;
        if (r < IT_UQ) { cvt_item<2>(inp(I_AWUQ) + (size_t)l * 768 * 2304, 768, 2304, (bf16*)(wl + W_UQ), inp(I_AGQ) + l * 768, scr, r, F.lane); continue; } r -= IT_UQ;
        if (r < IT_UKV) { cvt_item<0>(inp(I_AWUKV) + (size_t)l * 512 * 3072, 512, 3072, (bf16*)(wl + W_UKV), inp(I_AGKV) + l * 512, scr, r, F.lane); continue; } r -= IT_UKV;
        if (r < IT_GLU) { cvt_item<0>(inp(I_WGLU) + (size_t)l * 1024 * 1024, 1024, 1024, (bf16*)(wl + W_GLU), nullptr, scr, r, F.lane); continue; } r -= IT_GLU;
        if (r < IT_OUT) { cvt_item<0>(inp(I_WOUT) + (size_t)l * D * D, D, D, (bf16*)(wl + W_OUT), nullptr, scr, r, F.lane); continue; } r -= IT_OUT;
        if (r < IT_1) { cvt_item<0>(inp(I_WFF1) + (size_t)l * D * DFF, D, DFF, (bf16*)(wl + W_1), nullptr, scr, r, F.lane); continue; } r -= IT_1;
        cvt_item<0>(inp(I_WFF2) + (size_t)l * DFF * D, DFF, D, (bf16*)(wl + W_2), nullptr, scr, r, F.lane);
    }
    if (PSEL == 2) pacc += __builtin_amdgcn_s_memrealtime() - pt0_;
    ln_phase<true, false>(F, inp(I_X), inp(I_LNG), inp(I_LNB));
}
constexpr int S5_WLDS = 8192 + 16 * 272;
template <bool OUT>
__device__ __forceinline__ void s5_task(Frame& F, int layer, int b, int g, int o, LAS unsigned char* wl) {
    const int lane = F.lane, kq = lane >> 4, p = lane & 15;
    const unsigned char* sp = ws_base() + WS_S5P + layer * S5P_STRIDE;
    const float ar = ((const float*)(sp + S5P_A))[(g * 64 + lane) * 2], ai = ((const float*)(sp + S5P_A))[(g * 64 + lane) * 2 + 1];
    bf16x8 bbf[8];
#pragma unroll
    for (int ct = 0; ct < 8; ++ct) bbf[ct] = *(const bf16x8*)(sp + S5P_BB + ((size_t)(g * 8 + ct) * 64 + lane) * 16);
    bf16x8 cmf[4]; float dsk = 0.f;
    float* E = (float*)(ws_base() + WS_E);
    float hr = 0.f, hi = 0.f;
    if (OUT) {
#pragma unroll
        for (int ks = 0; ks < 4; ++ks) cmf[ks] = *(const bf16x8*)(sp + S5P_CM + ((size_t)(g * 4 + ks) * 64 + lane) * 16);
        dsk = inp(I_SD)[(layer * 64 + g) * 16 + p];
        const float pr = ((const float*)(sp + S5P_A512))[(g * 64 + lane) * 2], pi = ((const float*)(sp + S5P_A512))[(g * 64 + lane) * 2 + 1];
        for (int oo = 0; oo < o; ++oo) { const float er = E[((size_t)(b * 64 + g) * 8 + oo) * 128 + lane], ei = E[((size_t)(b * 64 + g) * 8 + oo) * 128 + 64 + lane];
            const float nr = pr * hr - pi * hi + er, ni = pr * hi + pi * hr + ei; hr = nr; hi = ni; }
    }
    LAS float* BUf = (LAS float*)wl; LAS unsigned short* Hs = (LAS unsigned short*)(wl + 8192);
    const bf16* PROJ = (const bf16*)(ws_base() + WS_PROJ); bf16* G = (bf16*)(ws_base() + WS_G);
    const size_t r0 = (size_t)b * SEQ + (size_t)o * 512;
    const bf16* up = PROJ + (r0 + p) * NPROJ + C_USSM + 16 * g + 8 * (kq & 1);
    bf16x8 nxt = (bf16x8){0, 0, 0, 0, 0, 0, 0, 0}, nx2 = nxt;
    if (kq < 2) { nxt = *(const bf16x8*)up; nx2 = *(const bf16x8*)(up + (size_t)16 * NPROJ); }
    const bf16* ue = PROJ + (r0 + 4 * kq) * NPROJ + C_USSM + 16 * g + p;
    unsigned short un[4] = {0, 0, 0, 0};
    if (OUT) {
#pragma unroll
        for (int r = 0; r < 4; ++r) un[r] = ue[(size_t)r * NPROJ];
    }
    for (int it = 0; it < 32; ++it) {
        const bf16x8 cur = nxt; nxt = nx2;
        if (it + 2 < 32 && kq < 2) nx2 = *(const bf16x8*)(up + (size_t)(it + 2) * 16 * NPROJ);
        unsigned short uc[4];
#pragma unroll
        for (int r = 0; r < 4; ++r) uc[r] = un[r];
        if (OUT && it + 1 < 32) {
#pragma unroll
            for (int r = 0; r < 4; ++r) un[r] = ue[(size_t)((it + 1) * 16 + r) * NPROJ];
        }
#pragma unroll
        for (int ct = 0; ct < 8; ++ct) { const f32x4 c = __builtin_amdgcn_mfma_f32_16x16x32_bf16(cur, bbf[ct], (f32x4){0.f, 0.f, 0.f, 0.f}, 0, 0, 0);
#pragma unroll
            for (int r = 0; r < 4; ++r) BUf[(kq * 4 + r) * 128 + ct * 16 + p] = c[r]; }
        asm volatile("" ::: "memory");
#pragma unroll
        for (int ps = 0; ps < 16; ++ps) { const float br = BUf[ps * 128 + lane], bi = BUf[ps * 128 + 64 + lane];
            const float nr = ar * hr - ai * hi + br, ni = ar * hi + ai * hr + bi; hr = nr; hi = ni;
            if (OUT) { Hs[ps * 136 + lane] = (unsigned short)f2bf(hr); Hs[ps * 136 + 64 + lane] = (unsigned short)f2bf(hi); } }
        asm volatile("" ::: "memory");
        if (OUT) {
            f32x4 y = (f32x4){0.f, 0.f, 0.f, 0.f};
#pragma unroll
            for (int ks = 0; ks < 4; ++ks) { const bf16x8 a = *(const LAS bf16x8*)(Hs + p * 136 + 32 * ks + 8 * kq); y = __builtin_amdgcn_mfma_f32_16x16x32_bf16(a, cmf[ks], y, 0, 0, 0); }
#pragma unroll
            for (int r = 0; r < 4; ++r) { const size_t row = r0 + it * 16 + kq * 4 + r; const float u = bf2f(uc[r]);
                const float v = y[r] + dsk * u, z = 0.7978845608028654f * (v + 0.044715f * v * v * v);
                G[row * 1024 + 16 * g + p] = (bf16)f2bf(v / (1.f + __expf(-2.f * z))); }
            asm volatile("" ::: "memory");
        }
    }
    if (!OUT) { E[((size_t)(b * 64 + g) * 8 + o) * 128 + lane] = hr; E[((size_t)(b * 64 + g) * 8 + o) * 128 + 64 + lane] = hi; }
}
template <bool OUT>
__device__ __forceinline__ void s5_phase(Frame& F, int layer) {
    const int gw = F.vcu * 8 + F.wave, NGW = F.G * 8;
    LAS unsigned char* wl = F.lds + F.wave * S5_WLDS;
    for (int task = gw; task < NB * 64 * 8; task += NGW) { const int o = task & 7, g = (task >> 3) & 63, b = task >> 9;
        if (!OUT && o == 7) continue;
        s5_task<OUT>(F, layer, b, g, o, wl); }
}

__device__ __forceinline__ float relu1(float x) { const int i = __builtin_bit_cast(int, x); return __builtin_bit_cast(float, i > 0 ? i : 0); }
template <bool PROBE> __device__ __forceinline__ void dsa_index_phase(Frame& F, int qword, unsigned long long& pacc) {
    const int lane = F.lane, wave = F.wave, r32 = lane & 31, hi = lane >> 5;
    const bf16* PROJ = (const bf16*)(ws_base() + WS_PROJ); u64* MASK = (u64*)(ws_base() + WS_MASK);
    LAS unsigned* sc = (LAS unsigned*)F.lds;
    volatile LAS unsigned* qs = (volatile LAS unsigned*)(F.lds + LDSCTL_OFF + 64);
    for (;;) {
        if (F.tid == 0) qs[0] = __hip_atomic_fetch_add(ctl_base() + CW_Q + 64 * qword, 1u, RLX_AGENT);
        __syncthreads();
        const unsigned idx = qs[0];
        __syncthreads();
        if (idx >= 2048u) break;
        const int t0 = 4088 - 8 * (int)(idx >> 2), b = (int)(idx & 3u), lim = 64 * ((t0 >> 6) + 1), nk64 = lim >> 6;
        const size_t rowq = (size_t)b * SEQ + t0;
        if (lim <= 256) { MASK[(rowq + wave) * 64 + lane] = lane < nk64 ? ~0ull : 0ull; continue; }
#pragma unroll 1
        for (int hb = 0; hb < 2; ++hb) {
            bf16x8 afr[2][4]; float wq[2][16];
#pragma unroll
            for (int bl = 0; bl < 2; ++bl)
#pragma unroll
                for (int ks = 0; ks < 4; ++ks) afr[bl][ks] = *(const bf16x8*)(PROJ + (rowq + 4 * hb + 2 * bl + (r32 >> 4)) * NPROJ + C_QI + (r32 & 15) * 64 + ks * 16 + 8 * hi);
#pragma unroll
            for (int bl = 0; bl < 2; ++bl)
#pragma unroll
                for (int r = 0; r < 16; ++r) wq[bl][r] = bf2f(PROJ[(rowq + 4 * hb + 2 * bl + (r >> 3)) * NPROJ + C_WI + (r & 3) + 8 * ((r >> 2) & 1) + 4 * hi]);
            const int ntile = lim >> 5;
            const bf16* kp = PROJ + ((size_t)b * SEQ + r32) * NPROJ + C_KI + 8 * hi;
            bf16x8 bn[4];
            if (wave < ntile) {
#pragma unroll
                for (int ks = 0; ks < 4; ++ks) bn[ks] = *(const bf16x8*)(kp + (size_t)wave * 32 * NPROJ + ks * 16);
            }
            for (int kt = wave; kt < ntile; kt += 8) {
                bf16x8 bc[4];
#pragma unroll
                for (int ks = 0; ks < 4; ++ks) bc[ks] = bn[ks];
                if (kt + 8 < ntile) {
#pragma unroll
                    for (int ks = 0; ks < 4; ++ks) bn[ks] = *(const bf16x8*)(kp + (size_t)(kt + 8) * 32 * NPROJ + ks * 16);
                }
#pragma unroll
                for (int bl = 0; bl < 2; ++bl) {
                    f32x16 c = {};
#pragma unroll
                    for (int ks = 0; ks < 4; ++ks) c = __builtin_amdgcn_mfma_f32_32x32x16_bf16(afr[bl][ks], bc[ks], c, 0, 0, 0);
                    float sA = 0.f, sB = 0.f;
#pragma unroll
                    for (int r = 0; r < 8; ++r) { sA = __builtin_fmaf(relu1(c[r]), wq[bl][r], sA); sB = __builtin_fmaf(relu1(c[8 + r]), wq[bl][8 + r], sB); }
                    auto rr = __builtin_amdgcn_permlane32_swap(__float_as_uint(sA), __float_as_uint(sB), false, false);
                    const float tot = __uint_as_float(rr[0]) + __uint_as_float(rr[1]);
                    unsigned ub = __float_as_uint(tot); ub = (ub & 0x80000000u) ? ~ub : (ub | 0x80000000u);
                    sc[(4 * hb + 2 * bl + hi) * 4096 + kt * 32 + r32] = ub;
                }
            }
        }
        __syncthreads();
        unsigned long long ps0_ = 0ull; if (PROBE) ps0_ = __builtin_amdgcn_s_memrealtime();
        {
            unsigned kv[64];
#pragma unroll
            for (int i = 0; i < 64; ++i) { const unsigned v = sc[wave * 4096 + i * 64 + lane]; kv[i] = i < nk64 ? v : 0u; }
            LAS unsigned* hist = (LAS unsigned*)(F.lds + LDSCTL_OFF + 1024 + wave * 1024);
            unsigned T = 0u;
#pragma unroll 1
            for (int bit = 31; bit >= 23; --bit) {
                const unsigned cand = T | (1u << bit); int cnt = 0;
#pragma unroll
                for (int i = 0; i < 64; ++i) cnt += (kv[i] >= cand) ? 1 : 0;
#pragma unroll
                for (int o = 1; o < 64; o <<= 1) cnt += __shfl_xor(cnt, o);
                T = cnt >= 256 ? cand : T;
            }
            int need;
            { int cab = 0; const unsigned nxt = T + (1u << 23);
              if (nxt > T) {
#pragma unroll
                  for (int i = 0; i < 64; ++i) cab += (kv[i] >= nxt) ? 1 : 0;
#pragma unroll
                  for (int o = 1; o < 64; o <<= 1) cab += __shfl_xor(cab, o); }
              need = __builtin_amdgcn_readfirstlane(256 - cab); }
#pragma unroll 1
            for (int pass = 0; pass < 3; ++pass) {
                const int shift = pass == 0 ? 15 : pass == 1 ? 7 : 0, nb = pass == 2 ? 7 : 8; const unsigned dm = (1u << nb) - 1u;
                *(LAS u32x4*)(hist + 4 * lane) = (u32x4){0u, 0u, 0u, 0u};
                const unsigned pfx = T >> (shift + nb);
#pragma unroll
                for (int i = 0; i < 64; ++i) { if (i < nk64) { const unsigned k = kv[i];
                    if ((k >> (shift + nb)) == pfx) (void)__hip_atomic_fetch_add(hist + ((k >> shift) & dm), 1u, __ATOMIC_RELAXED, __HIP_MEMORY_SCOPE_WORKGROUP); } }
                asm volatile("s_waitcnt lgkmcnt(0)" ::: "memory");
                const u32x4 hc = *(const LAS u32x4*)(hist + 4 * lane);
                const int sl = (int)(hc.x + hc.y + hc.z + hc.w); int suf = sl;
#pragma unroll
                for (int d = 1; d < 64; d <<= 1) { const int v = __shfl_down(suf, d); if (lane + d < 64) suf += v; }
                const int above = suf - sl;
                const int s3 = above + (int)hc.w, s2 = s3 + (int)hc.z, s1 = s2 + (int)hc.y, s0 = s1 + (int)hc.x;
                int dloc = -1, nloc = 0;
                if (s3 >= need && above < need) { dloc = 3; nloc = need - above; }
                else if (s2 >= need && s3 < need) { dloc = 2; nloc = need - s3; }
                else if (s1 >= need && s2 < need) { dloc = 1; nloc = need - s2; }
                else if (s0 >= need && s1 < need) { dloc = 0; nloc = need - s1; }
                const u64 fm = __ballot(dloc >= 0); const int src = fm ? __builtin_ctzll(fm) : 0;
                const int dstar = 4 * src + __builtin_amdgcn_readlane(dloc, src); need = __builtin_amdgcn_readlane(nloc, src);
                T |= (unsigned)dstar << shift;
                asm volatile("" ::: "memory");
            }
            int eqt = 0;
#pragma unroll
            for (int i = 0; i < 64; ++i) eqt += (kv[i] == T) ? 1 : 0;
#pragma unroll
            for (int o = 1; o < 64; o <<= 1) eqt += __shfl_xor(eqt, o);
            eqt = __builtin_amdgcn_readfirstlane(eqt);
            unsigned mlo = 0u, mhi = 0u;
            if (eqt == need) {
#define WL1(I) { const u64 w = __ballot(kv[I] >= T); const unsigned wl_ = (unsigned)w, wh_ = (unsigned)(w >> 32); \
                    asm volatile("s_nop 3\n\tv_writelane_b32 %0, %2, %4\n\tv_writelane_b32 %1, %3, %4" : "+v"(mlo), "+v"(mhi) : "s"(wl_), "s"(wh_), "n"(I)); }
#define WL4(I) WL1(I) WL1(I + 1) WL1(I + 2) WL1(I + 3)
#define WL16(I) WL4(I) WL4(I + 4) WL4(I + 8) WL4(I + 12)
                WL16(0) WL16(16) WL16(32) WL16(48)
#undef WL16
#undef WL4
#undef WL1
            } else {
                int nd = need;
#pragma unroll 1
                for (int i = 0; i < 64; ++i) {
                    unsigned kvi = 0u;
#pragma unroll
                    for (int j2 = 0; j2 < 64; ++j2) kvi = (j2 == i) ? kv[j2] : kvi;
                    u64 eq = __ballot(kvi == T); const u64 g1 = __ballot(kvi > T);
                    const int ce = __builtin_popcountll(eq);
                    if (ce > nd) { u64 tt = eq, kept = 0ull; for (int c = 0; c < nd; ++c) { const u64 low = tt & (0ull - tt); kept |= low; tt ^= low; } eq = kept; nd = 0; }
                    else nd -= ce;
                    const u64 w = g1 | eq;
                    if (lane == i) { mlo = (unsigned)w; mhi = (unsigned)(w >> 32); }
                }
            }
            const u64 mine = ((u64)mhi << 32) | mlo;
            MASK[(rowq + wave) * 64 + lane] = mine;
        }
        __syncthreads();
        if (PROBE) pacc += __builtin_amdgcn_s_memrealtime() - ps0_;
    }
}
namespace fa {
constexpr int SHM_V = 16384, DQK = 192, SHM_K = 64 * DQK * 2;
#define KSWZ(row, colB) ((row) * 256 + ((colB) ^ (((row) & 7) << 4)))
#define SBAR() __builtin_amdgcn_sched_barrier(0)
#define FA_BAR() asm volatile("s_waitcnt lgkmcnt(0)\n\ts_barrier" ::: "memory")
__device__ __forceinline__ int v_st(int k, int c) { const int kk = (k & ~0xC) | ((k & 4) << 1) | ((k & 8) >> 1); return ((kk >> 3) * 4 + (c >> 5)) * 512 + ((kk & 7) * 32 + (c & 31)) * 2; }
__device__ __forceinline__ int v_rd_base(int lane) { return ((lane & 3) << 3) | (((lane >> 2) & 3) << 6) | (((lane >> 4) & 1) << 5) | (((lane >> 5) & 1) << 8); }
constexpr int v_rd_off(int d0, int ks, int half) { return d0 * 512 + ks * 4096 + half * 2048; }
__device__ __forceinline__ int crow(int r, int hi) { return (r & 3) + 8 * (r >> 2) + 4 * hi; }
struct Args {
    const bf16* Q; int ldq; const bf16* Qr;
    const bf16* K; int ldk; const bf16* Kr; int ldkr; const bf16* V; int ldv;
    bf16* O; int ldo;
};
struct State { bf16x8 qr[DQK / 16]; f32x16 o[4]; f32x16 p0, p1; float m, l, alpha; bf16x8 sk0, sk1, sv0, sv1, skr; };

__device__ __forceinline__ void stage_load(const Args& A, State& S, int t1, int tid) {
    int tid2 = tid; asm volatile("" : "+v"(tid2));
    const int sr = tid2 >> 4, scc = (tid2 & 15) * 8; const size_t k1 = (size_t)t1 * 64;
    S.sv0 = *(const bf16x8*)(A.V + (k1 + sr) * A.ldv + scc); S.sv1 = *(const bf16x8*)(A.V + (k1 + 32 + sr) * A.ldv + scc);
    S.sk0 = *(const bf16x8*)(A.K + (k1 + sr) * A.ldk + scc); S.sk1 = *(const bf16x8*)(A.K + (k1 + 32 + sr) * A.ldk + scc);
    S.skr = *(const bf16x8*)(A.Kr + (k1 + (tid2 >> 3)) * A.ldkr + (tid2 & 7) * 8);
}
template <int NB_>
__device__ __forceinline__ void stage_write(State& S, char* lds, int tid) {
    int tid2 = tid; asm volatile("" : "+v"(tid2));
    const int sr = tid2 >> 4, scc = (tid2 & 15) * 8, kws = KSWZ(sr, scc * 2), rr_ = tid2 >> 3;
    char* V_lds = lds; char* K_lds = lds + 2 * SHM_V;
    asm volatile("s_waitcnt vmcnt(0)" ::: "memory");
    *(bf16x8*)(V_lds + NB_ * SHM_V + v_st(sr, scc)) = S.sv0; *(bf16x8*)(V_lds + NB_ * SHM_V + v_st(32 + sr, scc)) = S.sv1;
    *(bf16x8*)(K_lds + NB_ * SHM_K + kws) = S.sk0; *(bf16x8*)(K_lds + NB_ * SHM_K + kws + 32 * 256) = S.sk1;
    *(bf16x8*)(K_lds + NB_ * SHM_K + 16384 + rr_ * 128 + (((tid2 & 7) * 16) ^ ((rr_ & 7) << 4))) = S.skr;
}
template <int BUF>
__device__ __forceinline__ void seg_qk(State& S, char* lds, int tid) {
    const int lane = tid & 63, r32 = lane & 31, hi = lane >> 5;
    char* K_lds = lds + 2 * SHM_V;
    f32x16 p0 = {}, p1 = {};
    const char* kb[4];
#pragma unroll
    for (int dd = 0; dd < 4; ++dd) kb[dd] = K_lds + BUF * SHM_K + KSWZ(r32, (dd * 16 + hi * 8) * 2);
#pragma unroll
    for (int d0 = 0; d0 < 8; ++d0) { const char* a = kb[d0 & 3] + (d0 >> 2) * 128;
        const bf16x8 b0 = *(const bf16x8*)a, b1 = *(const bf16x8*)(a + 32 * 256);
        p0 = __builtin_amdgcn_mfma_f32_32x32x16_bf16(b0, S.qr[d0], p0, 0, 0, 0); p1 = __builtin_amdgcn_mfma_f32_32x32x16_bf16(b1, S.qr[d0], p1, 0, 0, 0); }
#pragma unroll
    for (int d0 = 0; d0 < 4; ++d0) { const char* a = K_lds + BUF * SHM_K + 16384 + r32 * 128 + ((d0 * 32 + hi * 16) ^ ((r32 & 7) << 4));
        const bf16x8 b0 = *(const bf16x8*)a, b1 = *(const bf16x8*)(a + 32 * 128);
        p0 = __builtin_amdgcn_mfma_f32_32x32x16_bf16(b0, S.qr[8 + d0], p0, 0, 0, 0); p1 = __builtin_amdgcn_mfma_f32_32x32x16_bf16(b1, S.qr[8 + d0], p1, 0, 0, 0); }
    float pmax = p0[0];
#pragma unroll
    for (int r = 1; r < 16; ++r) pmax = fmaxf(pmax, p0[r]);
#pragma unroll
    for (int r = 0; r < 16; ++r) pmax = fmaxf(pmax, p1[r]);
    { auto rr = __builtin_amdgcn_permlane32_swap(__float_as_uint(pmax), __float_as_uint(pmax), false, false); pmax = fmaxf(__uint_as_float(rr[0]), __uint_as_float(rr[1])); }
    float alpha = 1.f;
    if (!__all(pmax - S.m <= 8.f)) { const float mn = fmaxf(S.m, pmax); alpha = __builtin_amdgcn_exp2f(S.m - mn); S.m = mn; }
    const float mcur = S.m;
#pragma unroll
    for (int r = 0; r < 16; ++r) { p0[r] = __builtin_amdgcn_exp2f(p0[r] - mcur); p1[r] = __builtin_amdgcn_exp2f(p1[r] - mcur); }
    S.p0 = p0; S.p1 = p1; S.alpha = alpha;
}
template <int BUF>
__device__ __forceinline__ void seg_pv(State& S, char* lds, int tid) {
    const int wid = __builtin_amdgcn_readfirstlane(tid >> 6), lane = tid & 63, r32 = lane & 31, hi = lane >> 5;
    char* V_lds = lds;
    float* wsf = (float*)(lds + 2 * SHM_V + 2 * SHM_K) + wid * 64; float* al_l = wsf + 32;
    const f32x16 p0 = S.p0, p1 = S.p1; const float alpha = S.alpha;
    float ps = 0.f;
#pragma unroll
    for (int r = 0; r < 16; ++r) ps += p0[r] + p1[r];
    { auto rr = __builtin_amdgcn_permlane32_swap(__float_as_uint(ps), __float_as_uint(ps), false, false); ps = __uint_as_float(rr[0]) + __uint_as_float(rr[1]); }
    S.l = S.l * alpha + ps;
    bf16x8 pa0, pa1, pa2, pa3;
#define PK4(P, B_, OUT) do { unsigned a0 = cvtpk(P[B_+0], P[B_+1]), a1 = cvtpk(P[B_+2], P[B_+3]); unsigned b0 = cvtpk(P[B_+4], P[B_+5]), b1 = cvtpk(P[B_+6], P[B_+7]); \
    auto r0 = __builtin_amdgcn_permlane32_swap(a0, b0, false, false); auto r1 = __builtin_amdgcn_permlane32_swap(a1, b1, false, false); \
    u32x4 w = {r0[0], r1[0], r0[1], r1[1]}; OUT = __builtin_bit_cast(bf16x8, w); } while (0)
    PK4(p0, 0, pa0); PK4(p0, 8, pa1); PK4(p1, 0, pa2); PK4(p1, 8, pa3);
#undef PK4
    if (__any(alpha < 1.f)) { if (hi == 0) al_l[r32] = alpha; asm volatile("s_waitcnt lgkmcnt(0)" ::: "memory");
#pragma unroll
        for (int d_ = 0; d_ < 4; ++d_)
#pragma unroll
            for (int r = 0; r < 16; ++r) S.o[d_][r] *= al_l[crow(r, hi)]; }
    const int vb0 = (int)(uintptr_t)V_lds + v_rd_base(lane);
#define TRRD(dst, off) asm volatile("ds_read_b64_tr_b16 %0, %1 offset:%2" : "=&v"(dst) : "v"(vb0), "i"(off) : "memory")
#define PV_D0(d0) do { s16x4 l0, l1, l2, l3, h0, h1, h2, h3; constexpr int b_ = BUF * SHM_V + v_rd_off(d0, 0, 0); \
    TRRD(l0, b_); TRRD(h0, b_ + 2048); TRRD(l1, b_ + 4096); TRRD(h1, b_ + 6144); TRRD(l2, b_ + 8192); TRRD(h2, b_ + 10240); TRRD(l3, b_ + 12288); TRRD(h3, b_ + 14336); \
    asm volatile("s_waitcnt lgkmcnt(0)" ::: "memory"); SBAR(); \
    S.o[d0] = __builtin_amdgcn_mfma_f32_32x32x16_bf16(pa0, (bf16x8){l0[0], l0[1], l0[2], l0[3], h0[0], h0[1], h0[2], h0[3]}, S.o[d0], 0, 0, 0); \
    S.o[d0] = __builtin_amdgcn_mfma_f32_32x32x16_bf16(pa1, (bf16x8){l1[0], l1[1], l1[2], l1[3], h1[0], h1[1], h1[2], h1[3]}, S.o[d0], 0, 0, 0); \
    S.o[d0] = __builtin_amdgcn_mfma_f32_32x32x16_bf16(pa2, (bf16x8){l2[0], l2[1], l2[2], l2[3], h2[0], h2[1], h2[2], h2[3]}, S.o[d0], 0, 0, 0); \
    S.o[d0] = __builtin_amdgcn_mfma_f32_32x32x16_bf16(pa3, (bf16x8){l3[0], l3[1], l3[2], l3[3], h3[0], h3[1], h3[2], h3[3]}, S.o[d0], 0, 0, 0); } while (0)
    PV_D0(0); PV_D0(1); PV_D0(2); PV_D0(3);
#undef PV_D0
#undef TRRD
}
template <int BUF>
__device__ __forceinline__ void tile(const Args& A, State& S, int t, int NT, int my_last, int hb, char* lds, int tid) {
    const bool act = t <= my_last;
    if (hb == 0 && t + 1 < NT) stage_load(A, S, t + 1, tid);
    if (act) seg_qk<BUF>(S, lds, tid);
    if (hb == 1 && t + 1 < NT) stage_write<BUF ^ 1>(S, lds, tid);
    FA_BAR();
    if (hb == 1 && t + 2 < NT) stage_load(A, S, t + 2, tid);
    if (act) seg_pv<BUF>(S, lds, tid);
    if (hb == 0 && t + 1 < NT) stage_write<BUF ^ 1>(S, lds, tid);
    FA_BAR();
}
__device__ __forceinline__ void unit(const Args& A, int qb, char* lds) {
    int tid_ = threadIdx.x; asm volatile("" : "+v"(tid_));
    const int tid = tid_, wid = __builtin_amdgcn_readfirstlane(tid >> 6), lane = tid & 63, r32 = lane & 31, hi = lane >> 5, hb = wid >> 2;
    const int q0 = qb * 256, NT = 4 * qb + 4, my_last = 4 * qb + (wid >> 1);
    float* wsf = (float*)(lds + 2 * SHM_V + 2 * SHM_K) + wid * 64;
    State S;
    const bf16* qp = A.Q + (size_t)(q0 + wid * 32 + r32) * A.ldq + hi * 8;
#pragma unroll
    for (int d0 = 0; d0 < 8; ++d0) S.qr[d0] = *(const bf16x8*)(qp + d0 * 16);
    { const bf16* qrp = A.Qr + (size_t)(q0 + wid * 32 + r32) * A.ldq + hi * 8;
#pragma unroll
      for (int d0 = 0; d0 < 4; ++d0) S.qr[8 + d0] = *(const bf16x8*)(qrp + d0 * 16); }
    S.m = -1e30f; S.l = 0.f;
#pragma unroll
    for (int d = 0; d < 4; ++d) S.o[d] = f32x16{};
    stage_load(A, S, 0, tid); stage_write<0>(S, lds, tid);
    __syncthreads();
    if (hb == 1) { stage_load(A, S, 1, tid); FA_BAR(); }
    for (int t = 0; t < NT; t += 2) { tile<0>(A, S, t, NT, my_last, hb, lds, tid); tile<1>(A, S, t + 1, NT, my_last, hb, lds, tid); }
    if (hb == 0) FA_BAR();
    float* li_l = wsf;
    if (hi == 0) li_l[r32] = S.l; asm volatile("s_waitcnt lgkmcnt(0)" ::: "memory");
    float rli[16];
#pragma unroll
    for (int r = 0; r < 16; ++r) rli[r] = __builtin_amdgcn_rcpf(li_l[crow(r, hi)]);
    bf16* Ow = A.O + (size_t)(q0 + wid * 32) * A.ldo;
#pragma unroll
    for (int r = 0; r < 16; ++r) { const int orow = crow(r, hi);
#pragma unroll
        for (int d0 = 0; d0 < 4; ++d0) { const float v = S.o[d0][r] * rli[r]; const float vn = __shfl_xor(v, 1);
            if ((r32 & 1) == 0) *(unsigned*)(Ow + (size_t)orow * A.ldo + d0 * 32 + r32) = cvtpk(v, vn); } }
    __syncthreads();
}
#undef KSWZ
#undef SBAR
#undef FA_BAR
}

__device__ const unsigned char MLA_ORDER[96] = {120, 121, 122, 123, 124, 125, 112, 113, 114, 115, 116, 117, 104, 105, 106, 107, 108, 109, 96, 97, 98, 99, 100, 101, 88, 89, 90, 91, 92, 93, 80, 81, 82, 72, 83, 73, 84, 74, 75, 48, 85, 49, 76, 50, 77, 40, 56, 51, 52, 41, 53, 42, 64, 57, 65, 58, 66, 43, 67, 59, 68, 60, 69, 61, 44, 45, 32, 33, 34, 35, 24, 25, 36, 37, 26, 27, 16, 17, 28, 29, 8, 9, 18, 19, 20, 21, 0, 1, 2, 10, 11, 12, 13, 3, 4, 5};
__device__ __forceinline__ void attn_phase(Frame& F, int qbase) {
    volatile LAS unsigned* qs = (volatile LAS unsigned*)(F.lds + LDSCTL_OFF + 64);
    const bf16* PROJ = (const bf16*)(ws_base() + WS_PROJ); const bf16* QA = (const bf16*)(ws_base() + WS_QA); const bf16* KV = (const bf16*)(ws_base() + WS_KV); bf16* MIX = (bf16*)(ws_base() + WS_MIX);
    int x = (int)((unsigned)__builtin_amdgcn_s_getreg((3 << 11) | 20) & 7u), tries = 0;
    while (tries < 8) {
        if (F.tid == 0) qs[0] = __hip_atomic_fetch_add(ctl_base() + CW_Q + 64 * (qbase + x), 1u, RLX_AGENT);
        __syncthreads();
        const unsigned idx = qs[0];
        __syncthreads();
        if (idx >= 96u) { x = (x + 1) & 7; ++tries; continue; }
        const int ent = MLA_ORDER[idx], bh = x * 6 + (ent & 7), qb = ent >> 3, b = bh / 12, h = bh - b * 12;
        const size_t rb = (size_t)b * SEQ;
        fa::Args A;
        A.Q = QA + rb * NQA + h * 128; A.ldq = NQA; A.Qr = QA + rb * NQA + 1536 + h * 64; A.K = KV + rb * NKV + h * 256; A.ldk = NKV; A.Kr = PROJ + rb * NPROJ + C_KROPE; A.ldkr = NPROJ;
        A.V = KV + rb * NKV + h * 256 + 128; A.ldv = NKV; A.O = MIX + rb * D + h * 128; A.ldo = D;
        fa::unit(A, qb, (char*)F.lds);
    }
}
namespace dg {
constexpr int WLDS = 9216;
constexpr int T5_OFF = 8 * WLDS;
__device__ __forceinline__ int voff(int row, int ch) { return 256 * row + 16 * (ch ^ (((row & 3) << 2) | ((row >> 2) & 3))); }
__device__ __forceinline__ void query(const bf16* PROJ, const u64* MASK, bf16* MIX, int b, int t, LAS unsigned char* wl, const LAS float* t5l, int lane) {
    const int kq = lane >> 4, c16 = lane & 15;
    LAS unsigned short* list = (LAS unsigned short*)wl; LAS unsigned char* vt = wl + 1024;
    const size_t rowb = (size_t)b * SEQ;
    int nsel;
    { const u64 w = MASK[(rowb + t) * 64 + lane]; const int cnt = __builtin_popcountll(w); int inc = cnt;
#pragma unroll
      for (int d = 1; d < 64; d <<= 1) { const int v = __shfl_up(inc, d); if (lane >= d) inc += v; }
      int off = inc - cnt; nsel = __shfl(inc, 63);
      u64 ww = w; while (ww) { const int bp = __builtin_ctzll(ww); list[off++] = (unsigned short)(lane * 64 + bp); ww &= ww - 1; }
      for (int p = nsel + lane; p < 256; p += 64) list[p] = 0; }
    asm volatile("s_waitcnt lgkmcnt(0)" ::: "memory");
    bf16x8 qf[4];
#pragma unroll
    for (int ks = 0; ks < 4; ++ks) { qf[ks] = (bf16x8){0, 0, 0, 0, 0, 0, 0, 0}; if (c16 < 12) qf[ks] = *(const bf16x8*)(PROJ + (rowb + t) * NPROJ + C_QC + c16 * 128 + 32 * ks + 8 * kq); }
    f32x4 st[16];
    const bf16* kbase = PROJ + rowb * NPROJ + C_KC + 8 * kq;
    bf16x8 kb[4][4];
#pragma unroll
    for (int T = 0; T < 4; ++T) { const unsigned ki = list[T * 16 + c16];
#pragma unroll
        for (int ks = 0; ks < 4; ++ks) kb[T][ks] = *(const bf16x8*)(kbase + (size_t)ki * NPROJ + 32 * ks); }
#pragma unroll
    for (int T = 0; T < 16; ++T) {
        f32x4 c = (f32x4){0.f, 0.f, 0.f, 0.f};
#pragma unroll
        for (int ks = 0; ks < 4; ++ks) c = __builtin_amdgcn_mfma_f32_16x16x32_bf16(kb[T & 3][ks], qf[ks], c, 0, 0, 0);
        st[T] = c;
        if (T + 4 < 16) { const unsigned ki = list[(T + 4) * 16 + c16];
#pragma unroll
            for (int ks = 0; ks < 4; ++ks) kb[T & 3][ks] = *(const bf16x8*)(kbase + (size_t)ki * NPROJ + 32 * ks); }
    }
    const LAS float* tb = t5l + (c16 < 12 ? c16 : 0) * 192 + 128 - t;
    float mx = -__builtin_inff();
#pragma unroll
    for (int T = 0; T < 16; ++T) { const u32x2 iw = *(const LAS u32x2*)(list + T * 16 + 4 * kq);
#pragma unroll
        for (int r = 0; r < 4; ++r) { const int ki = (int)((r & 1) ? (iw[r >> 1] >> 16) : (iw[r >> 1] & 0xffffu)); int rel = ki - t; rel = rel < -128 ? -128 : rel;
            float s = st[T][r] + tb[t + rel]; if (T * 16 + 4 * kq + r >= nsel) s = -__builtin_inff(); st[T][r] = s; mx = fmaxf(mx, s); } }
    mx = fmaxf(mx, __shfl_xor(mx, 16)); mx = fmaxf(mx, __shfl_xor(mx, 32));
    float sum = 0.f;
#pragma unroll
    for (int T = 0; T < 16; ++T)
#pragma unroll
        for (int r = 0; r < 4; ++r) { const float p = __builtin_amdgcn_exp2f(st[T][r] - mx); st[T][r] = p; sum += p; }
    sum += __shfl_xor(sum, 16); sum += __shfl_xor(sum, 32);
    bf16x8 pf[8];
#pragma unroll
    for (int s = 0; s < 8; ++s) { u32x4 w; w.x = cvtpk(st[2 * s][0], st[2 * s][1]); w.y = cvtpk(st[2 * s][2], st[2 * s][3]); w.z = cvtpk(st[2 * s + 1][0], st[2 * s + 1][1]); w.w = cvtpk(st[2 * s + 1][2], st[2 * s + 1][3]);
        pf[s] = __builtin_bit_cast(bf16x8, w); }
    f32x4 o[8];
#pragma unroll
    for (int dt = 0; dt < 8; ++dt) o[dt] = (f32x4){0.f, 0.f, 0.f, 0.f};
    const bf16* vbase = PROJ + rowb * NPROJ + C_VC + 8 * c16;
    u32x4 vn[2][8];
#pragma unroll
    for (int s = 0; s < 2; ++s)
#pragma unroll
        for (int i = 0; i < 8; ++i) { const int rho = kq + 4 * i; const unsigned vi = list[(2 * s + ((rho >> 2) & 1)) * 16 + 4 * (rho >> 3) + (rho & 3)]; vn[s][i] = *(const u32x4*)(vbase + (size_t)vi * NPROJ); }
    const int q4 = c16 >> 2, p4 = c16 & 3;
    const int vtb = (int)(uintptr_t)vt;
#pragma unroll
    for (int s = 0; s < 8; ++s) {
#pragma unroll
        for (int i = 0; i < 8; ++i) { const int rho = kq + 4 * i; *(LAS u32x4*)(vt + voff(rho, c16)) = vn[s & 1][i]; }
        if (s + 2 < 8) {
#pragma unroll
            for (int i = 0; i < 8; ++i) { const int rho = kq + 4 * i; const unsigned vi = list[(2 * (s + 2) + ((rho >> 2) & 1)) * 16 + 4 * (rho >> 3) + (rho & 3)]; vn[s & 1][i] = *(const u32x4*)(vbase + (size_t)vi * NPROJ); }
        }
        s16x4 lo[8], hi[8];
#pragma unroll
        for (int dt = 0; dt < 8; ++dt) {
            const int a1 = vtb + voff(8 * kq + q4, 2 * dt + (p4 >> 1)) + 8 * (p4 & 1), a2 = vtb + voff(8 * kq + 4 + q4, 2 * dt + (p4 >> 1)) + 8 * (p4 & 1);
            asm volatile("ds_read_b64_tr_b16 %0, %1" : "=&v"(lo[dt]) : "v"(a1) : "memory");
            asm volatile("ds_read_b64_tr_b16 %0, %1" : "=&v"(hi[dt]) : "v"(a2) : "memory"); }
        asm volatile("s_waitcnt lgkmcnt(0)" ::: "memory"); __builtin_amdgcn_sched_barrier(0);
#pragma unroll
        for (int dt = 0; dt < 8; ++dt)
            o[dt] = __builtin_amdgcn_mfma_f32_16x16x32_bf16((bf16x8){lo[dt][0], lo[dt][1], lo[dt][2], lo[dt][3], hi[dt][0], hi[dt][1], hi[dt][2], hi[dt][3]}, pf[s], o[dt], 0, 0, 0);
    }
    const float rl = 1.f / sum;
    if (c16 < 12) { bf16* op = MIX + (rowb + t) * D + 2560 + c16 * 128 + 4 * kq;
#pragma unroll
        for (int dt = 0; dt < 8; ++dt) { u32x2 w; w.x = cvtpk(o[dt][0] * rl, o[dt][1] * rl); w.y = cvtpk(o[dt][2] * rl, o[dt][3] * rl); *(u32x2*)(op + 16 * dt) = w; } }
    asm volatile("s_waitcnt lgkmcnt(0)" ::: "memory");
}
}
__device__ __forceinline__ void dsa_gather_phase(Frame& F, int qbase) {
    volatile LAS unsigned* qs = (volatile LAS unsigned*)(F.lds + LDSCTL_OFF + 64);
    const bf16* PROJ = (const bf16*)(ws_base() + WS_PROJ); const u64* MASK = (const u64*)(ws_base() + WS_MASK); bf16* MIX = (bf16*)(ws_base() + WS_MIX);
    LAS float* t5l = (LAS float*)(F.lds + dg::T5_OFF);
    for (int i = F.tid; i < 12 * 192; i += 512) t5l[i] = ((const float*)(ws_base() + WS_T5))[i];
    int x = (int)((unsigned)__builtin_amdgcn_s_getreg((3 << 11) | 20) & 7u), tries = 0;
    while (tries < 8) {
        if (F.tid == 0) qs[0] = __hip_atomic_fetch_add(ctl_base() + CW_Q + 64 * (qbase + x), 1u, RLX_AGENT);
        __syncthreads();
        const unsigned idx = qs[0];
        __syncthreads();
        if (idx >= 256u) { x = (x + 1) & 7; ++tries; continue; }
        const int b = x >> 1, t = ((x & 1) * 256 + (int)idx) * 8 + F.wave;
        dg::query(PROJ, MASK, MIX, b, t, F.lds + F.wave * dg::WLDS, t5l, F.lane);
    }
}
struct KArgs { const float* in[26]; float* out; unsigned char* ws; };
static_assert(sizeof(KArgs) == 224, "kernarg layout");
constexpr int NWAVES = 8;
#ifndef PHASE_MASK
#define PHASE_MASK 0xFFFF
#endif
#ifndef PROBE_MASK
#define PROBE_MASK 0
#endif
#ifndef PROBE_MULT
#define PROBE_MULT 4
#endif
__global__ void __launch_bounds__(NWAVES * 64, 2) trunk_fwd(KArgs args) {
    extern __shared__ __attribute__((aligned(16))) unsigned char lds_raw[];
    Frame F;
    F.lds = (LAS unsigned char*)lds_raw;
#define RELAUNDER() do { int t_ = threadIdx.x; asm volatile("" : "+v"(t_)); F.tid = t_; F.lane = t_ & 63; F.wave = __builtin_amdgcn_readfirstlane(t_ >> 6); } while (0)
    RELAUNDER();
    F.G = gridDim.x; { const int bx = blockIdx.x; F.vcu = (F.G % 8 == 0) ? (bx % 8) * (F.G / 8) + bx / 8 : bx; }
    for (int u = F.tid; u < (LDS_BYTES - LDSCTL_OFF) / 4; u += NWAVES * 64) ((LAS unsigned*)(F.lds + LDSCTL_OFF))[u] = 0u;
    __syncthreads();
    (void)xcd_barrier_post(ctl_base() + CW_BAR, (volatile LAS unsigned*)(F.lds + LDSCTL_OFF));
#define GRID_BAR() do { XcdBarrier b_; b_.bar = ctl_base() + CW_BAR; b_.x = xb_xcc_id(); b_.st = (volatile LAS unsigned*)(F.lds + LDSCTL_OFF); xcd_barrier(b_); } while (0)
    unsigned char* ws = ws_base();
    unsigned long long pr_last = 0ull, pr_acc = 0ull;
    if (PROBE_MASK) pr_last = __builtin_amdgcn_s_memrealtime();
#define PSTAMP(id) do { if (PROBE_MASK) { const unsigned long long n_ = __builtin_amdgcn_s_memrealtime(); if ((PROBE_MASK >> (id)) & 1) pr_acc += n_ - pr_last; pr_last = n_; } } while (0)
    bf16* HB = (bf16*)(ws + WS_HB); bf16* PROJ = (bf16*)(ws + WS_PROJ); bf16* QA = (bf16*)(ws + WS_QA); bf16* KVb = (bf16*)(ws + WS_KV);
    bf16* Gb = (bf16*)(ws + WS_G); bf16* MIX = (bf16*)(ws + WS_MIX); bf16* FFH = (bf16*)(ws + WS_FFH); float* SS = (float*)(ws + WS_SS);
    const float* cosA = (const float*)(ws + WS_COSA); const float* sinA = (const float*)(ws + WS_SINA); const float* cosI = (const float*)(ws + WS_COSI); const float* sinI = (const float*)(ws + WS_SINI);

    p0_prologue<(PROBE_MASK >> 21) & 3>(F, pr_acc);
    GRID_BAR();
    PSTAMP(0);
#pragma unroll 1
    for (int l = 0; l < DEPTH; ++l) {
        unsigned char* wl = ws + WS_W0 + (size_t)l * W_LSTRIDE;
        { pg8::Gemm g{HB, (const bf16*)(wl + W_IN), M, NPROJ, D, D}; pg8::StaticOrder S; S.init(M, NPROJ, F.G, (int)blockIdx.x);
          pg8::EpiProj E{PROJ, SS, cosA, sinA, cosI, sinI};
          pg8::gemm_phase<pg8::EpiProj, pg8::StaticOrder, true, true>(F.lds, g, S, E); }
        GRID_BAR();
        PSTAMP(1);
        if (PHASE_MASK & 1) {
          { pg8::Gemm g{PROJ + C_QLAT, (const bf16*)(wl + W_UQ), M, NQA, 768, NPROJ}; pg8::StaticOrder S; S.init(M, NQA, F.G, (int)blockIdx.x);
            pg8::EpiUp<true> E{QA, SS, cosA, sinA};
            pg8::gemm_phase<pg8::EpiUp<true>, pg8::StaticOrder, true, true>(F.lds, g, S, E); }
          { pg8::Gemm g{PROJ + C_KVLAT, (const bf16*)(wl + W_UKV), M, NKV, 512, NPROJ}; pg8::StaticOrder S; S.init(M, NKV, F.G, (int)blockIdx.x);
            pg8::EpiUp<false> E{KVb, SS, cosA, sinA};
            pg8::gemm_phase<pg8::EpiUp<false>, pg8::StaticOrder, true, true>(F.lds, g, S, E); }
        }
        PSTAMP(10); RELAUNDER(); if (PHASE_MASK & 2) s5_phase<false>(F, l);
        PSTAMP(11); RELAUNDER(); if (PHASE_MASK & 4) dsa_index_phase<((PROBE_MASK >> 20) & 1) != 0>(F, l * 32 + 0, pr_acc);
        GRID_BAR();
        PSTAMP(2);
        RELAUNDER(); if (PHASE_MASK & 2) s5_phase<true>(F, l);
        PSTAMP(13); RELAUNDER(); if (PHASE_MASK & 1) attn_phase(F, l * 32 + 8);
        GRID_BAR();
        PSTAMP(3);
        if (PHASE_MASK & 2) {
          pg8::Gemm g{Gb, (const bf16*)(wl + W_GLU), M, 1024, 1024, 1024}; pg8::StaticOrder S; S.init(M, 1024, F.G, (int)blockIdx.x);
          pg8::EpiGlu E{MIX, Gb, inp(I_BGLU) + l * 1024};
          pg8::gemm_phase<pg8::EpiGlu, pg8::StaticOrder, true, true>(F.lds, g, S, E); }
        PSTAMP(15); RELAUNDER(); if (PHASE_MASK & 4) dsa_gather_phase(F, l * 32 + 16);
        GRID_BAR();
        PSTAMP(4);
        { pg8::Gemm g{MIX, (const bf16*)(wl + W_OUT), M, D, D, D}; pg8::StaticOrder S; S.init(M, D, F.G, (int)blockIdx.x);
          pg8::EpiRes E{HB};
          pg8::gemm_phase<pg8::EpiRes, pg8::StaticOrder, true, true>(F.lds, g, S, E); }
        GRID_BAR();
        PSTAMP(5);
        RELAUNDER(); ln_phase<false, false>(F, nullptr, inp(I_LN1G) + l * D, inp(I_LN1B) + l * D);
        GRID_BAR();
        PSTAMP(6);
        { pg8::Gemm g{HB, (const bf16*)(wl + W_1), M, DFF, D, D}; pg8::StaticOrder S; S.init(M, DFF, F.G, (int)blockIdx.x);
          pg8::EpiRelu2 E{FFH};
          pg8::gemm_phase<pg8::EpiRelu2, pg8::StaticOrder, true, true>(F.lds, g, S, E); }
        GRID_BAR();
        PSTAMP(7);
        { pg8::Gemm g{FFH, (const bf16*)(wl + W_2), M, D, DFF, DFF}; pg8::StaticOrder S; S.init(M, D, F.G, (int)blockIdx.x);
          pg8::EpiRes E{HB};
          pg8::gemm_phase<pg8::EpiRes, pg8::StaticOrder, true, true>(F.lds, g, S, E); }
        GRID_BAR();
        PSTAMP(8);
        RELAUNDER(); if (l + 1 < DEPTH) ln_phase<false, false>(F, nullptr, inp(I_LN2G) + l * D, inp(I_LN2B) + l * D); else ln_phase<false, true>(F, nullptr, inp(I_LN2G) + l * D, inp(I_LN2B) + l * D);
        if (l + 1 < DEPTH) GRID_BAR();
        PSTAMP(9);
    }
    if (PROBE_MASK) { if (blockIdx.x == 0 && threadIdx.x == 0) { const unsigned long long t0_ = __builtin_amdgcn_s_memrealtime(), w_ = pr_acc * PROBE_MULT; while (__builtin_amdgcn_s_memrealtime() - t0_ < w_) __builtin_amdgcn_s_sleep(8); } }
}

extern "C" void kernel_launch(void* const* d_in, const int* in_sizes, int n_in, void* d_out, int out_size, void* d_ws, size_t ws_size, hipStream_t stream) {
    static int grid = 0;
    if (grid == 0) {
        if (n_in != 26 || in_sizes[0] != M * D || out_size != M * D || ws_size < WS_END) { fprintf(stderr, "kernel_launch: unexpected shapes (n_in %d, out %d, ws %zu)\n", n_in, out_size, ws_size); grid = -1; return; }
        int dev = 0, cus = 0;
        if (hipGetDevice(&dev) != hipSuccess || hipDeviceGetAttribute(&cus, hipDeviceAttributeMultiprocessorCount, dev) != hipSuccess) { grid = -1; return; }
        if (hipFuncSetAttribute((const void*)trunk_fwd, hipFuncAttributeMaxDynamicSharedMemorySize, LDS_BYTES) != hipSuccess) { fprintf(stderr, "kernel_launch: hipFuncSetAttribute failed\n"); grid = -1; return; }
        int per_cu = 0;
        if (hipOccupancyMaxActiveBlocksPerMultiprocessor(&per_cu, (const void*)trunk_fwd, NWAVES * 64, LDS_BYTES) != hipSuccess || per_cu < 1) { fprintf(stderr, "kernel_launch: occupancy query says %d\n", per_cu); }
        (void)hipGetLastError();
        grid = cus;
    }
    if (grid < 0) return;
    if (hipMemsetAsync((char*)d_ws + WS_CTL, 0, CTL_BYTES, stream) != hipSuccess) return;
    KArgs a{};
    for (int i = 0; i < 26; ++i) a.in[i] = (const float*)d_in[i];
    a.out = (float*)d_out; a.ws = (unsigned char*)d_ws;
    hipLaunchKernelGGL(trunk_fwd, dim3(grid), dim3(NWAVES * 64), LDS_BYTES, stream, a);
}
```

```cpp
#include <hip/hip_runtime.h>
#include <cstdio>
#include <cstdint>
#include <cmath>

#define LAS __attribute__((address_space(3)))
#define GAS __attribute__((address_space(1)))
typedef unsigned short bf16;
typedef short bf16x8 __attribute__((ext_vector_type(8)));
typedef short s16x4 __attribute__((ext_vector_type(4)));
typedef float f32x2 __attribute__((ext_vector_type(2)));
typedef float f32x4 __attribute__((ext_vector_type(4)));
typedef float f32x16 __attribute__((ext_vector_type(16)));
typedef unsigned u32x2 __attribute__((ext_vector_type(2)));
typedef unsigned u32x4 __attribute__((ext_vector_type(4)));
typedef unsigned long long u64;

constexpr int SEQ = 4096, NB = 4, M = NB * SEQ, D = 4096, DFF = 16384, DEPTH = 2;
constexpr int NPROJ = 5376;
constexpr int C_QLAT = 0, C_KVLAT = 768, C_USSM = 1280, C_QC = 2304, C_KC = 3840, C_VC = 3968, C_QI = 4096, C_KROPE = 5120, C_KI = 5184, C_WI = 5248, NPROJ_USED = 5264;
constexpr int NQA = 2304, NKV = 3072;
constexpr float ALPHA = 1.4142135623730951f;
constexpr float LOG2E = 1.4426950408889634f;
constexpr float C2_A = 0.07216878364870322f * LOG2E;
constexpr float C2_C = 0.08838834764831845f * LOG2E;
constexpr float LN_EPS = 1e-5f, RMS_EPS = 1e-6f;

constexpr size_t MiB = 1u << 20;
constexpr size_t WS_CTL = 0, CTL_BYTES = 1 * MiB;
constexpr size_t WS_COSA = 1 * MiB, WS_SINA = WS_COSA + 512 * 1024, WS_COSI = 2 * MiB, WS_SINI = WS_COSI + 256 * 1024, WS_T5 = 2 * MiB + 512 * 1024;
constexpr size_t WS_S5P = 3 * MiB, S5P_STRIDE = 1 * MiB;
constexpr size_t S5P_A = 0, S5P_A512 = 32 * 1024, S5P_D = 64 * 1024, S5P_BB = 128 * 1024  , S5P_CM = 640 * 1024  ;
constexpr size_t WS_SS = 5 * MiB;
constexpr size_t WS_E = 7 * MiB;
constexpr size_t WS_MASK = 8 * MiB;
constexpr size_t WS_W0 = 16 * MiB, W_LSTRIDE = 340 * MiB;
constexpr size_t W_IN = 0, W_UQ = 42 * MiB, W_UKV = 46 * MiB, W_GLU = 49 * MiB, W_OUT = 51 * MiB, W_1 = 83 * MiB, W_2 = 211 * MiB;
constexpr size_t WS_HB = 696 * MiB;
constexpr size_t WS_OV = 824 * MiB;
constexpr size_t WS_FFH = WS_OV;
constexpr size_t WS_PROJ = WS_OV, WS_QA = WS_OV + 168 * MiB, WS_KV = WS_OV + 240 * MiB, WS_G = WS_OV + 336 * MiB, WS_MIX = WS_OV + 368 * MiB;
constexpr size_t WS_END = WS_OV + 512 * MiB;
static_assert(WS_W0 + 2 * W_LSTRIDE <= WS_HB && WS_MIX + (size_t)M * D * 2 <= WS_END && WS_PROJ + (size_t)M * NPROJ * 2 <= WS_QA, "ws map");
constexpr int CW_TMO = 0, CW_BAR = 4096, CW_Q = 16384;

constexpr int RING_BYTES = 131072, LDSCTL_OFF = RING_BYTES, LDS_BYTES = 147456;

#define RLX_AGENT __ATOMIC_RELAXED, __HIP_MEMORY_SCOPE_AGENT
__device__ __forceinline__ unsigned f2bf(float f) { unsigned u = __builtin_bit_cast(unsigned, f); return (u + 0x7fffu + ((u >> 16) & 1u)) >> 16; }
__device__ __forceinline__ float bf2f(unsigned h) { return __builtin_bit_cast(float, h << 16); }
typedef __bf16 bf16x2_t __attribute__((ext_vector_type(2)));
__device__ __forceinline__ unsigned cvtpk(float lo, float hi) { const f32x2 v = {lo, hi}; const bf16x2_t b = __builtin_convertvector(v, bf16x2_t); return __builtin_bit_cast(unsigned, b); }
__device__ __forceinline__ float wave_sum(float v) {
#pragma unroll
    for (int o = 1; o < 64; o <<= 1) v += __shfl_xor(v, o);
    return v;
}
namespace pg8 {
#define PG8_LAS __attribute__((address_space(3)))
typedef unsigned short bf16_t;
typedef short bf16x8 __attribute__((ext_vector_type(8)));
typedef float f32x4 __attribute__((ext_vector_type(4)));
typedef unsigned u32x4 __attribute__((ext_vector_type(4)));
constexpr int BM = 256, BK = 64, HALF = 128, HTB = HALF * BK * 2  , STAGE_BYTES = 8 * HTB, NXCD = 8, WGM = 8;

__host__ __device__ __forceinline__ int lds_byte(int r, int c) { const int st = (r >> 4) * 2 + (c >> 5), rr = r & 15, cc = c & 31, ob = rr * 64 + cc * 2; return st * 1024 + (ob ^ (((ob >> 9) & 1) << 5)); }
__host__ __device__ __forceinline__ void stage_rc(int b, int& R, int& C) { const int st = b / 1024, sb = b % 1024, swz = sb ^ (((sb >> 9) & 1) << 5); R = (st >> 1) * 16 + swz / 64; C = (st & 1) * 32 + (swz % 64) / 2; }
__host__ __device__ __forceinline__ int perm32(int rho) { const int n = rho >> 4, i = rho & 15; return 8 * (i >> 2) + 4 * n + (i & 3); }

struct Unit { int pm, pn; };
struct Gemm { const bf16_t* A; const bf16_t* Bt; int M, N, K, lda; };

struct StaticOrder {
    int nM, nN, nwg, G, c;
    __host__ __device__ void init(int M, int N, int G_, int c_) { nM = M / BM; nN = N / BM; nwg = nM * nN; G = G_; c = c_; }
    __host__ __device__ bool next(int i, Unit& u) const {
        const long L = (long)i * G + c; if (L >= nwg) return false;
        int wgid = (int)L; { const int q = nwg / NXCD, r = nwg % NXCD, xcd = wgid % NXCD, off = wgid / NXCD; wgid = (xcd < r ? xcd * (q + 1) : r * (q + 1) + (xcd - r) * q) + off; }
        const int nig = WGM * nN, gid = wgid / nig, fm = gid * WGM, gsz = (nM - fm) < WGM ? (nM - fm) : WGM;
        u.pm = fm + ((wgid % nig) % gsz); u.pn = (wgid % nig) / gsz; return true;
    }
    __device__ __forceinline__ void a_ready(const Unit&) const {}
    __device__ __forceinline__ void done(const Unit&) const {}
};
template <class Epi, class Sched, bool ALIGN_EPI = false, bool SP2 = false>
__device__ __forceinline__ void gemm_phase(PG8_LAS unsigned char* lds, const Gemm g, const Sched& S, const Epi& E) {
    int tid_ = threadIdx.x; asm volatile("" : "+v"(tid_));
    const int tid = tid_, wid = __builtin_amdgcn_readfirstlane(tid >> 6), lane = tid & 63, wr = wid >> 2, wc = wid & 3, fr = lane & 15, fq = lane >> 4;
    const int K = g.K, nt = K / BK;
    unsigned voffA[2], voffB[2];
#pragma unroll
    for (int i = 0; i < 2; ++i) { int R, C; stage_rc(tid * 16 + i * 8192, R, C); const int Rb = Epi::PERM ? ((R & ~31) + perm32(R & 31)) : R;
        voffA[i] = (unsigned)(R * g.lda + C) * 2u; voffB[i] = (unsigned)(Rb * K + C) * 2u; }
    const size_t kstep = (size_t)(BK * 2);
    const size_t hstepA = (size_t)HALF * g.lda * 2, hstepB = (size_t)HALF * K * 2;
    const size_t tstepA = 2 * hstepA, tstepB = 2 * hstepB;
    const unsigned ldsw = (unsigned)wid * 1024u;
    const int aoff = lds_byte(wr * 64 + fr, fq * 8), boff = lds_byte(wc * 32 + fr, fq * 8);
#define PG8_SA(b, h) (((b) * 2 + (h)) * HTB)
#define PG8_SB(b, h) ((4 + (b) * 2 + (h)) * HTB)
#define PG8_STAGE(bufoff, gbase, voff) do { _Pragma("unroll") for (int _i = 0; _i < 2; ++_i) \
        __builtin_amdgcn_global_load_lds((const unsigned*)((const char*)(gbase) + (voff)[_i]), (PG8_LAS unsigned*)(lds + (bufoff) + ldsw + _i * 8192), 16, 0, 0); } while (0)
#define PG8_LDA(dst, b, h) do { _Pragma("unroll") for (int m = 0; m < 4; ++m) _Pragma("unroll") for (int k = 0; k < 2; ++k) dst[m][k] = *(const PG8_LAS bf16x8*)(lds + PG8_SA(b, h) + aoff + m * 2048 + k * 1024); } while (0)
#define PG8_LDB(dst, b, h) do { _Pragma("unroll") for (int n = 0; n < 2; ++n) _Pragma("unroll") for (int k = 0; k < 2; ++k) dst[n][k] = *(const PG8_LAS bf16x8*)(lds + PG8_SB(b, h) + boff + n * 2048 + k * 1024); } while (0)
#define PG8_MMA(ai, bj, At, Bt) do { __builtin_amdgcn_s_setprio(1); _Pragma("unroll") for (int m = 0; m < 4; ++m) _Pragma("unroll") for (int n = 0; n < 2; ++n) _Pragma("unroll") for (int k = 0; k < 2; ++k) \
        acc[ai][bj][m][n] = __builtin_amdgcn_mfma_f32_16x16x32_bf16(Bt[n][k], At[m][k], acc[ai][bj][m][n], 0, 0, 0); __builtin_amdgcn_s_setprio(0); } while (0)
#define PG8_WAIT_V(n) asm volatile("s_waitcnt vmcnt(" #n ")" ::: "memory")
#define PG8_WAIT_L(n) asm volatile("s_waitcnt lgkmcnt(" #n ")" ::: "memory")
#define PG8_BAR __builtin_amdgcn_s_barrier()
#define PG8_SCHED __builtin_amdgcn_sched_barrier(0)
    Unit cur, nxt; int ui = 0;
    if (!S.next(0, cur)) return;
    f32x4 acc[2][2][4][2];
#pragma unroll
    for (int a = 0; a < 2; ++a)
#pragma unroll
        for (int b = 0; b < 2; ++b)
#pragma unroll
            for (int m = 0; m < 4; ++m)
#pragma unroll
                for (int n = 0; n < 2; ++n) acc[a][b][m][n] = (f32x4){0.f, 0.f, 0.f, 0.f};
    bf16x8 At[4][2], B0[2][2], B1[2][2];
    const char* cA = (const char*)g.A + (size_t)cur.pm * tstepA; const char* cB = (const char*)g.Bt + (size_t)cur.pn * tstepB;
    S.a_ready(cur);
    if constexpr (SP2) {
        PG8_STAGE(PG8_SB(0, 0), cB, voffB); PG8_STAGE(PG8_SB(0, 1), cB + hstepB, voffB); PG8_STAGE(PG8_SA(0, 0), cA, voffA); PG8_STAGE(PG8_SA(0, 1), cA + hstepA, voffA);
        if (wr == 1) PG8_BAR;
        PG8_WAIT_V(2); PG8_BAR;
        PG8_STAGE(PG8_SB(1, 0), cB + kstep, voffB); PG8_STAGE(PG8_SA(1, 0), cA + kstep, voffA); PG8_STAGE(PG8_SB(1, 1), cB + hstepB + kstep, voffB);
        PG8_WAIT_V(6); PG8_BAR;
    } else {
        PG8_STAGE(PG8_SB(0, 0), cB, voffB); PG8_STAGE(PG8_SA(0, 0), cA, voffA); PG8_STAGE(PG8_SB(0, 1), cB + hstepB, voffB); PG8_STAGE(PG8_SA(0, 1), cA + hstepA, voffA);
        if (wr == 1) PG8_BAR;
        PG8_WAIT_V(4); PG8_BAR;
        PG8_STAGE(PG8_SB(1, 0), cB + kstep, voffB); PG8_STAGE(PG8_SA(1, 0), cA + kstep, voffA); PG8_STAGE(PG8_SB(1, 1), cB + hstepB + kstep, voffB);
        PG8_WAIT_V(6); PG8_BAR;
    }
    for (;;) {
        const bool has_next = S.next(ui + 1, nxt);
        const char* nA = has_next ? (const char*)g.A + (size_t)nxt.pm * tstepA : cA; const char* nB = has_next ? (const char*)g.Bt + (size_t)nxt.pn * tstepB : cB;
        for (int t = 0; t < nt; t += 2) {
            const bool last = (t == nt - 2);
            const char* a1 = cA + (size_t)(t + 1) * kstep;
            const char* a2 = last ? nA : cA + (size_t)(t + 2) * kstep; const char* b2 = last ? nB : cB + (size_t)(t + 2) * kstep;
            const char* a3 = a2 + kstep; const char* b3 = b2 + kstep;
            if (last && has_next) S.a_ready(nxt);
            if constexpr (SP2) {
            PG8_LDB(B0, 0, 0); PG8_LDB(B1, 0, 1); PG8_SCHED; PG8_LDA(At, 0, 0); PG8_STAGE(PG8_SA(1, 1), a1 + hstepA, voffA);
            PG8_WAIT_V(8); PG8_WAIT_L(0); PG8_BAR; PG8_MMA(0, 0, At, B0); PG8_MMA(0, 1, At, B1); PG8_BAR; PG8_SCHED;
            PG8_LDA(At, 0, 1); PG8_STAGE(PG8_SB(0, 0), b2, voffB); PG8_STAGE(PG8_SB(0, 1), b2 + hstepB, voffB); PG8_STAGE(PG8_SA(0, 0), a2, voffA);
            PG8_WAIT_V(8); PG8_WAIT_L(0); PG8_BAR; PG8_MMA(1, 0, At, B0); PG8_MMA(1, 1, At, B1); PG8_BAR; PG8_SCHED;
            PG8_LDB(B0, 1, 0); PG8_LDB(B1, 1, 1); PG8_SCHED; PG8_LDA(At, 1, 0); PG8_STAGE(PG8_SA(0, 1), a2 + hstepA, voffA);
            PG8_WAIT_V(8); PG8_WAIT_L(0); PG8_BAR; PG8_MMA(0, 0, At, B0); PG8_MMA(0, 1, At, B1); PG8_BAR; PG8_SCHED;
            PG8_LDA(At, 1, 1); PG8_STAGE(PG8_SB(1, 0), b3, voffB); PG8_STAGE(PG8_SB(1, 1), b3 + hstepB, voffB); PG8_STAGE(PG8_SA(1, 0), a3, voffA);
            PG8_WAIT_V(8); PG8_WAIT_L(0); PG8_BAR; PG8_MMA(1, 0, At, B0); PG8_MMA(1, 1, At, B1); PG8_BAR; PG8_SCHED;
            } else {
            PG8_LDB(B0, 0, 0); PG8_SCHED; PG8_LDA(At, 0, 0); PG8_STAGE(PG8_SA(1, 1), a1 + hstepA, voffA);
            PG8_WAIT_L(8); PG8_BAR; PG8_WAIT_L(0); PG8_MMA(0, 0, At, B0); PG8_BAR; PG8_SCHED;
            PG8_LDB(B1, 0, 1); PG8_STAGE(PG8_SB(0, 0), b2, voffB);
            PG8_BAR; PG8_WAIT_L(0); PG8_MMA(0, 1, At, B1); PG8_BAR;
            PG8_LDA(At, 0, 1); PG8_STAGE(PG8_SA(0, 0), a2, voffA);
            PG8_BAR; PG8_WAIT_L(0); PG8_MMA(1, 0, At, B0); PG8_BAR; PG8_SCHED;
            PG8_STAGE(PG8_SB(0, 1), b2 + hstepB, voffB);
            PG8_WAIT_V(6); PG8_BAR; PG8_MMA(1, 1, At, B1); PG8_BAR;
            PG8_LDB(B0, 1, 0); PG8_SCHED; PG8_LDA(At, 1, 0); PG8_STAGE(PG8_SA(0, 1), a2 + hstepA, voffA);
            PG8_WAIT_L(8); PG8_BAR; PG8_WAIT_L(0); PG8_MMA(0, 0, At, B0); PG8_BAR; PG8_SCHED;
            PG8_LDB(B1, 1, 1); PG8_STAGE(PG8_SB(1, 0), b3, voffB);
            PG8_BAR; PG8_WAIT_L(0); PG8_MMA(0, 1, At, B1); PG8_BAR;
            PG8_LDA(At, 1, 1); PG8_STAGE(PG8_SA(1, 0), a3, voffA);
            PG8_BAR; PG8_WAIT_L(0); PG8_MMA(1, 0, At, B0); PG8_BAR; PG8_SCHED;
            PG8_STAGE(PG8_SB(1, 1), b3 + hstepB, voffB);
            PG8_WAIT_V(6); PG8_BAR; PG8_MMA(1, 1, At, B1); PG8_BAR;
            }
        }
        if constexpr (ALIGN_EPI) { if (wr == 0) PG8_BAR; }
        if constexpr (!Epi::AFTER_DRAIN) { E(acc, cur, wr, wc, fr, fq); S.done(cur); }
        if (!has_next) break;
#pragma unroll
        for (int a = 0; a < 2; ++a)
#pragma unroll
            for (int b = 0; b < 2; ++b)
#pragma unroll
                for (int m = 0; m < 4; ++m)
#pragma unroll
                    for (int n = 0; n < 2; ++n) acc[a][b][m][n] = (f32x4){0.f, 0.f, 0.f, 0.f};
        cur = nxt; cA = nA; cB = nB; ++ui;
        if constexpr (ALIGN_EPI) { if (wr == 1) PG8_BAR; }
    }
    PG8_WAIT_V(0);
    if constexpr (!ALIGN_EPI) { if (wr == 0) PG8_BAR; }
    PG8_BAR;
    if constexpr (Epi::AFTER_DRAIN) { E.fused(acc, cur, wr, wc, fr, fq, lds, wid, lane); S.done(cur); }
#undef PG8_SA
#undef PG8_SB
#undef PG8_STAGE
#undef PG8_LDA
#undef PG8_LDB
#undef PG8_MMA
#undef PG8_WAIT_V
#undef PG8_WAIT_L
#undef PG8_BAR
#undef PG8_SCHED
}
}
namespace pg8 {
struct EpiProj {
    static constexpr bool PERM = true, AFTER_DRAIN = false;
    bf16_t* O; float* ss; const float* cosA; const float* sinA; const float* cosI; const float* sinI;
    __device__ __forceinline__ void operator()(const f32x4 (&acc)[2][2][4][2], const Unit& u, int wr, int wc, int fr, int fq) const {
        const int row0 = u.pm * BM + wr * 64 + fr, pn = u.pn, col0 = pn * BM + wc * 32 + 8 * fq;
        int mode[2], f0[2];
#pragma unroll
        for (int bj = 0; bj < 2; ++bj) {
            int md = 0, f = 0;
            if (pn >= 9 && pn <= 14) md = 1;
            else if (pn >= 16 && pn <= 19) { if ((wc & 1) == 0) { md = 3; f = 4 * fq; } }
            else if (pn == 20 && bj == 0) { if (wc < 2) { md = 2; f = 16 * wc + 4 * fq; } else if (wc == 2) { md = 3; f = 4 * fq; } }
            mode[bj] = md; f0[bj] = f;
        }
#pragma unroll
        for (int ai = 0; ai < 2; ++ai)
#pragma unroll
            for (int m = 0; m < 4; ++m) {
                const int row = row0 + ai * HALF + m * 16, t = row & (SEQ - 1);
                bf16_t* rowp = O + (size_t)row * NPROJ + col0; float sq = 0.f;
#pragma unroll
                for (int bj = 0; bj < 2; ++bj) {
                    f32x4 v0 = acc[ai][bj][m][0], v1 = acc[ai][bj][m][1];
                    if (mode[bj] == 1) { v0 = v0 * C2_C; v1 = v1 * C2_C; }
                    else if (mode[bj] >= 2) {
                        const float* ct = mode[bj] == 2 ? cosA + t * 32 : cosI + t * 16; const float* st = mode[bj] == 2 ? sinA + t * 32 : sinI + t * 16;
                        const f32x4 c = *(const f32x4*)(ct + f0[bj]), s = *(const f32x4*)(st + f0[bj]);
                        const f32x4 o0 = v0 * c - v1 * s, o1 = v1 * c + v0 * s; v0 = o0; v1 = o1;
                    }
                    u32x4 w; w.x = cvtpk(v0[0], v0[1]); w.y = cvtpk(v0[2], v0[3]); w.z = cvtpk(v1[0], v1[1]); w.w = cvtpk(v1[2], v1[3]);
                    *(u32x4*)(rowp + bj * HALF) = w;
                    if (pn < 5) {
#pragma unroll
                        for (int e = 0; e < 4; ++e) { const float lo = bf2f(w[e] & 0xffffu), hi = bf2f(w[e] >> 16); sq += lo * lo + hi * hi; }
                    }
                }
                if (pn < 5) { sq += __shfl_xor(sq, 16); sq += __shfl_xor(sq, 32); if (fq == 0) ss[(size_t)(pn * 4 + wc) * M + row] = sq; }
            }
    }
};
template <bool QUP> struct EpiUp {
    static constexpr bool PERM = true, AFTER_DRAIN = false;
    bf16_t* O; const float* ss; const float* cosA; const float* sinA;
    __device__ __forceinline__ void operator()(const f32x4 (&acc)[2][2][4][2], const Unit& u, int wr, int wc, int fr, int fq) const {
        constexpr int ldc = QUP ? NQA : NKV, s0 = QUP ? 0 : 12, ns = QUP ? 12 : 8; constexpr float inv = QUP ? 1.f / 768.f : 1.f / 512.f, sc = QUP ? C2_A : 1.f;
        const int row0 = u.pm * BM + wr * 64 + fr, col0 = u.pn * BM + wc * 32 + 8 * fq;
        const bool rope = QUP && u.pn >= 6; const int f0 = 16 * (wc & 1) + 4 * fq;
#pragma unroll
        for (int ai = 0; ai < 2; ++ai)
#pragma unroll
            for (int m = 0; m < 4; ++m) {
                const int row = row0 + ai * HALF + m * 16, t = row & (SEQ - 1);
                float s = 0.f;
#pragma unroll
                for (int k = 0; k < ns / 4; ++k) s += ss[(size_t)(s0 + fq * (ns / 4) + k) * M + row];
                s += __shfl_xor(s, 16); s += __shfl_xor(s, 32);
                const float rs = sc / sqrtf(s * inv + RMS_EPS);
                bf16_t* rowp = O + (size_t)row * ldc + col0;
#pragma unroll
                for (int bj = 0; bj < 2; ++bj) {
                    f32x4 v0 = acc[ai][bj][m][0] * rs, v1 = acc[ai][bj][m][1] * rs;
                    if (rope) { const f32x4 c = *(const f32x4*)(cosA + t * 32 + f0), sn = *(const f32x4*)(sinA + t * 32 + f0);
                        const f32x4 o0 = v0 * c - v1 * sn, o1 = v1 * c + v0 * sn; v0 = o0; v1 = o1; }
                    u32x4 w; w.x = cvtpk(v0[0], v0[1]); w.y = cvtpk(v0[2], v0[3]); w.z = cvtpk(v1[0], v1[1]); w.w = cvtpk(v1[2], v1[3]);
                    *(u32x4*)(rowp + bj * HALF) = w;
                }
            }
    }
};
struct EpiGlu {
    static constexpr bool PERM = true, AFTER_DRAIN = false;
    bf16_t* O; const bf16_t* G; const float* bias;
    __device__ __forceinline__ void operator()(const f32x4 (&acc)[2][2][4][2], const Unit& u, int wr, int wc, int fr, int fq) const {
        const int row0 = u.pm * BM + wr * 64 + fr, col0 = u.pn * BM + wc * 32 + 8 * fq;
        f32x4 bv[2][2];
#pragma unroll
        for (int bj = 0; bj < 2; ++bj)
#pragma unroll
            for (int n = 0; n < 2; ++n) bv[bj][n] = *(const f32x4*)(bias + col0 + bj * HALF + 4 * n);
#pragma unroll
        for (int ai = 0; ai < 2; ++ai)
#pragma unroll
            for (int m = 0; m < 4; ++m) {
                const int row = row0 + ai * HALF + m * 16;
#pragma unroll
                for (int bj = 0; bj < 2; ++bj) {
                    const u32x4 gw = *(const u32x4*)(G + (size_t)row * 1024 + col0 + bj * HALF);
                    float o[8];
#pragma unroll
                    for (int e = 0; e < 8; ++e) { const float z = acc[ai][bj][m][e >> 2][e & 3] + bv[bj][e >> 2][e & 3];
                        const float gg = (e & 1) ? bf2f(gw[e >> 1] >> 16) : bf2f(gw[e >> 1] & 0xffffu);
                        o[e] = gg / (1.f + __expf(-z)); }
                    u32x4 w; w.x = cvtpk(o[0], o[1]); w.y = cvtpk(o[2], o[3]); w.z = cvtpk(o[4], o[5]); w.w = cvtpk(o[6], o[7]);
                    *(u32x4*)(O + (size_t)row * D + 1536 + col0 + bj * HALF) = w;
                }
            }
    }
};
struct EpiRes {
    static constexpr bool PERM = true, AFTER_DRAIN = false;
    bf16_t* H;
    __device__ __forceinline__ void operator()(const f32x4 (&acc)[2][2][4][2], const Unit& u, int wr, int wc, int fr, int fq) const {
        const int row0 = u.pm * BM + wr * 64 + fr, col0 = u.pn * BM + wc * 32 + 8 * fq;
#pragma unroll
        for (int ai = 0; ai < 2; ++ai)
#pragma unroll
            for (int m = 0; m < 4; ++m) { bf16_t* rowp = H + (size_t)(row0 + ai * HALF + m * 16) * D + col0;
                u32x4 hv[2];
#pragma unroll
                for (int bj = 0; bj < 2; ++bj) hv[bj] = *(const u32x4*)(rowp + bj * HALF);
#pragma unroll
                for (int bj = 0; bj < 2; ++bj) { float o[8];
#pragma unroll
                    for (int e = 0; e < 8; ++e) { const float hh = (e & 1) ? bf2f(hv[bj][e >> 1] >> 16) : bf2f(hv[bj][e >> 1] & 0xffffu); o[e] = __builtin_fmaf(hh, ALPHA, acc[ai][bj][m][e >> 2][e & 3]); }
                    u32x4 w; w.x = cvtpk(o[0], o[1]); w.y = cvtpk(o[2], o[3]); w.z = cvtpk(o[4], o[5]); w.w = cvtpk(o[6], o[7]);
                    *(u32x4*)(rowp + bj * HALF) = w; } }
    }
};
struct EpiRelu2 {
    static constexpr bool PERM = true, AFTER_DRAIN = false;
    bf16_t* O;
    __device__ __forceinline__ void operator()(const f32x4 (&acc)[2][2][4][2], const Unit& u, int wr, int wc, int fr, int fq) const {
        const int row0 = u.pm * BM + wr * 64 + fr, col0 = u.pn * BM + wc * 32 + 8 * fq;
#pragma unroll
        for (int ai = 0; ai < 2; ++ai)
#pragma unroll
            for (int m = 0; m < 4; ++m) { bf16_t* rowp = O + (size_t)(row0 + ai * HALF + m * 16) * DFF + col0;
#pragma unroll
                for (int bj = 0; bj < 2; ++bj) { f32x4 v0 = acc[ai][bj][m][0], v1 = acc[ai][bj][m][1];
#pragma unroll
                    for (int e = 0; e < 4; ++e) { const float a = fmaxf(v0[e], 0.f), b = fmaxf(v1[e], 0.f); v0[e] = a * a; v1[e] = b * b; }
                    u32x4 w; w.x = cvtpk(v0[0], v0[1]); w.y = cvtpk(v0[2], v0[3]); w.z = cvtpk(v1[0], v1[1]); w.w = cvtpk(v1[2], v1[3]);
                    *(u32x4*)(rowp + bj * HALF) = w; } }
    }
};
}
#define XB_TMO      128
#define XB_XCNT(j)  (256  + 64 * (j))
#define XB_XSUB(j)  (1280 + 64 * (j))
#define XB_XGEN(j)  (2304 + 64 * (j))
#define XB_TOP      3328
#define XB_TOPGEN   3392
#define XCD_BAR_WORDS 3456
#define XB_SPIN_CAP (1u << 18)

__device__ __forceinline__ unsigned xb_ld(unsigned* p)              { return __hip_atomic_load(p, __ATOMIC_RELAXED, __HIP_MEMORY_SCOPE_AGENT); }
__device__ __forceinline__ unsigned xb_add(unsigned* p, unsigned v) { return __hip_atomic_fetch_add(p, v, __ATOMIC_RELAXED, __HIP_MEMORY_SCOPE_AGENT); }
__device__ __forceinline__ unsigned xb_xcc_id() { return (unsigned)__builtin_amdgcn_s_getreg((3 << 11) | 20) & 0xFu; }
#define XB_SPIN(cond, bar) do { unsigned _sp = 0; while (cond) { __builtin_amdgcn_s_sleep(1); \
    if ((++_sp & 255u) == 0u) { if (xb_ld(&(bar)[XB_TMO])) break; if (_sp > XB_SPIN_CAP) { atomicAdd(&(bar)[XB_TMO], 1u); break; } } } } while (0)

struct XcdBarrier {
    unsigned* bar; unsigned x;
    volatile LAS unsigned* st;
};

__device__ __forceinline__ XcdBarrier xcd_barrier_post(unsigned* bar, volatile LAS unsigned* st) {
    XcdBarrier b; b.bar = bar; b.x = xb_xcc_id(); b.st = st;
    if (threadIdx.x == 0) (void)xb_add(&bar[XB_XCNT(b.x)], 1u);
    return b;
}
__device__ __forceinline__ void xcd_barrier_complete(unsigned* bar, unsigned x, unsigned& nloc, unsigned& nx) {
    const unsigned G = gridDim.x * gridDim.y * gridDim.z;
    unsigned sum, cnt, mine, sp = 0u;
    for (;;) {
        sum = 0u; cnt = 0u; mine = 0u;
#pragma unroll
        for (unsigned j = 0; j < 16; ++j) { const unsigned c = xb_ld(&bar[XB_XCNT(j)]); sum += c; cnt += (c > 0u) ? 1u : 0u; mine = (j == x) ? c : mine; }
        if (sum == G) break;
        __builtin_amdgcn_s_sleep(1);
        if ((++sp & 255u) == 0u) { if (xb_ld(&bar[XB_TMO])) break; if (sp > XB_SPIN_CAP) { atomicAdd(&bar[XB_TMO], 1u); break; } }
    }
    nloc = mine > 0u ? mine : 1u; nx = cnt > 0u ? cnt : 1u;
}

__device__ __forceinline__ void xcd_barrier(const XcdBarrier& b) {
    asm volatile("s_waitcnt vmcnt(0)" ::: "memory");
    __syncthreads();
    if (threadIdx.x == 0) {
        unsigned* bar = b.bar;
        __builtin_amdgcn_s_waitcnt(0);
        unsigned nloc = b.st[0], nx = b.st[1];
        if (nloc == 0u) { xcd_barrier_complete(bar, b.x, nloc, nx); b.st[0] = nloc; b.st[1] = nx; }
        const unsigned old = xb_add(&bar[XB_XSUB(b.x)], 1u);
        const unsigned gen = old / nloc;
        if (old + 1u == (gen + 1u) * nloc) {
            __builtin_amdgcn_fence(__ATOMIC_RELEASE, "agent");
            asm volatile("s_waitcnt vmcnt(0)" ::: "memory");
            const unsigned og = xb_add(&bar[XB_TOP], 1u);
            const unsigned tg = og / nx;
            if (og + 1u == (tg + 1u) * nx) xb_add(&bar[XB_TOPGEN], 1u);
            else XB_SPIN(xb_ld(&bar[XB_TOPGEN]) == tg, bar);
            __builtin_amdgcn_fence(__ATOMIC_ACQUIRE, "agent");
            xb_add(&bar[XB_XGEN(b.x)], 1u);
            asm volatile("s_waitcnt vmcnt(0)" ::: "memory");
        } else {
            XB_SPIN(xb_ld(&bar[XB_XGEN(b.x)]) == gen, bar);
            __builtin_amdgcn_fence(__ATOMIC_ACQUIRE, "agent");
            asm volatile("s_waitcnt vmcnt(0)" ::: "memory");
        }
    }
    __syncthreads();
}

struct Frame {
    LAS unsigned char* lds;
    int tid, lane, wave, vcu, G;
};
#define CAS __attribute__((address_space(4)))
__device__ __forceinline__ const CAS char* karg_base() { const CAS char* p = (const CAS char*)__builtin_amdgcn_kernarg_segment_ptr(); asm volatile("" : "+s"(p)); return p; }
__device__ __forceinline__ const float* inp(int i) { return *(const float* const CAS*)(karg_base() + 8 * i); }
__device__ __forceinline__ float* x_base() { return *(float* const CAS*)(karg_base() + 208); }
__device__ __forceinline__ unsigned char* ws_base() { return *(unsigned char* const CAS*)(karg_base() + 216); }
__device__ __forceinline__ unsigned* ctl_base() { return (unsigned*)(ws_base() + WS_CTL); }
enum { I_X = 0, I_LNG, I_LNB, I_RELB, I_WIN, I_AGQ, I_AWUQ, I_AGKV, I_AWUKV, I_LRE, I_LIM, I_LSTEP, I_BRE, I_BIM, I_CRE, I_CIM, I_SD, I_WGLU, I_BGLU, I_WOUT, I_LN1G, I_LN1B, I_WFF1, I_WFF2, I_LN2G, I_LN2B };

__device__ __forceinline__ void dsincos(double x, double& s, double& c) {
    const double kq = rint(x * 0.6366197723675814);
    double r = fma(-kq, 1.5707963267948966, x); r = fma(-kq, 6.123233995736766e-17, r);
    const int q = (int)((long long)kq & 3);
    const double r2 = r * r;
    const double sp = r * (1.0 + r2 * (-1.0 / 6.0 + r2 * (1.0 / 120.0 + r2 * (-1.0 / 5040.0 + r2 * (1.0 / 362880.0 + r2 * (-1.0 / 39916800.0 + r2 * (1.0 / 6227020800.0 + r2 * (-1.0 / 1307674368000.0))))))));
    const double cp = 1.0 + r2 * (-0.5 + r2 * (1.0 / 24.0 + r2 * (-1.0 / 720.0 + r2 * (1.0 / 40320.0 + r2 * (-1.0 / 3628800.0 + r2 * (1.0 / 479001600.0 + r2 * (-1.0 / 87178291200.0 + r2 * (1.0 / 20922789888000.0))))))));
    s = (q == 0) ? sp : (q == 1) ? cp : (q == 2) ? -sp : -cp;
    c = (q == 0) ? cp : (q == 1) ? -sp : (q == 2) ? -cp : sp;
}
__device__ __forceinline__ void s5_coef(const Frame& F, int l, int g, int n, double& ar, double& ai, double& cr, double& ci) {
    const double lr = (double)inp(I_LRE)[(l * 64 + g) * 64 + n], li = (double)inp(I_LIM)[(l * 64 + g) * 64 + n];
    const double dt = exp((double)inp(I_LSTEP)[l * 64 + g]);
    const double mag = exp(lr * dt); double s, c; dsincos(fabs(li * dt), s, c); if (li * dt < 0.0) s = -s;
    ar = mag * c; ai = mag * s;
    const double den = lr * lr + li * li, nr = ar - 1.0, ni = ai;
    cr = (nr * lr + ni * li) / den; ci = (ni * lr - nr * li) / den;
}
__device__ __forceinline__ int il32(int d) { return d < 16 ? 8 * (d >> 2) + (d & 3) : 8 * ((d - 16) >> 2) + 4 + (d & 3); }
__device__ __forceinline__ int il64(int d) { return d < 32 ? 8 * (d >> 2) + (d & 3) : 8 * ((d - 32) >> 2) + 4 + (d & 3); }
__device__ __forceinline__ int phys_win(int n) {
    if (n < 1280) return n;
    if (n < 1344) return C_KROPE + il64(n - 1280);
    if (n < 2368) return C_USSM + (n - 1344);
    if (n < 3904) return C_QC + (n - 2368);
    if (n < 4160) return C_KC + (n - 3904);
    if (n < 5184) { const int j = n - 4160, d = j & 63; return C_QI + (j & ~63) + (d < 32 ? il32(d) : d); }
    if (n < 5248) { const int d = n - 5184; return C_KI + (d < 32 ? il32(d) : d); }
    return C_WI + (n - 5248);
}
__device__ __forceinline__ int phys_uq(int n) { const int h = n / 192, o = n - h * 192; return o < 128 ? h * 128 + o : 1536 + h * 64 + il64(o - 128); }
template <int PM  >
__device__ __forceinline__ void cvt_item(const float* W, int K, int N, bf16* WT, const float* gk, LAS float* scr, int item, int lane) {
    const int nblk = (N + 31) / 32, kb = item / nblk, nb = item - kb * nblk, k0 = 64 * kb, n0 = 32 * nb;
    const int rr = lane >> 3, n4 = (lane & 7) * 4;
#pragma unroll
    for (int i = 0; i < 8; ++i) { const int row = i * 8 + rr;
        f32x4 v = (f32x4){0.f, 0.f, 0.f, 0.f}; if (n0 + n4 < N) v = *(const f32x4*)(W + (size_t)(k0 + row) * N + n0 + n4);
        LAS float* d = scr + row * 33 + n4; d[0] = v.x; d[1] = v.y; d[2] = v.z; d[3] = v.w; }
    asm volatile("s_waitcnt lgkmcnt(0)" ::: "memory");
    const int c = lane & 7;
    float gs[8];
#pragma unroll
    for (int j = 0; j < 8; ++j) gs[j] = gk ? gk[k0 + 8 * c + j] : 1.f;
#pragma unroll
    for (int j = 0; j < 4; ++j) { const int n = (lane >> 3) + 8 * j; const LAS float* s = scr + (8 * c) * 33 + n;
        if (n0 + n < N) { const int pr = PM == 1 ? phys_win(n0 + n) : PM == 2 ? phys_uq(n0 + n) : n0 + n;
            u32x4 o; o.x = f2bf(s[0] * gs[0]) | (f2bf(s[33] * gs[1]) << 16); o.y = f2bf(s[66] * gs[2]) | (f2bf(s[99] * gs[3]) << 16);
            o.z = f2bf(s[132] * gs[4]) | (f2bf(s[165] * gs[5]) << 16); o.w = f2bf(s[198] * gs[6]) | (f2bf(s[231] * gs[7]) << 16);
            *(u32x4*)(WT + (size_t)pr * K + k0 + 8 * c) = o; } }
    asm volatile("s_waitcnt lgkmcnt(0)" ::: "memory");
}
template <bool IN_F32>
__device__ __forceinline__ void ln_load(const float* xrow, const bf16* hrow, f32x4 (&v)[16], int lane) {
    if (IN_F32) {
#pragma unroll
        for (int j = 0; j < 16; ++j) v[j] = *(const f32x4*)(xrow + 4 * lane + 256 * j);
    } else {
#pragma unroll
        for (int j = 0; j < 8; ++j) { const u32x4 w = *(const u32x4*)(hrow + 8 * lane + 512 * j);
            v[2 * j] = (f32x4){bf2f(w.x & 0xffffu), bf2f(w.x >> 16), bf2f(w.y & 0xffffu), bf2f(w.y >> 16)}; v[2 * j + 1] = (f32x4){bf2f(w.z & 0xffffu), bf2f(w.z >> 16), bf2f(w.w & 0xffffu), bf2f(w.w >> 16)}; }
    }
}
template <bool IN_F32, bool OUT_F32>
__device__ __forceinline__ void ln_finish(f32x4 (&v)[16], const float* g, const float* b, float* orow, bf16* hrow, int lane) {
    float s = 0.f;
#pragma unroll
    for (int j = 0; j < 16; ++j) s += (v[j].x + v[j].y) + (v[j].z + v[j].w);
    const float mean = wave_sum(s) * (1.f / D); float s2 = 0.f;
#pragma unroll
    for (int j = 0; j < 16; ++j) { v[j] = v[j] - mean; s2 += (v[j].x * v[j].x + v[j].y * v[j].y) + (v[j].z * v[j].z + v[j].w * v[j].w); }
    const float rstd = 1.f / sqrtf(wave_sum(s2) * (1.f / D) + LN_EPS);
    if (IN_F32) {
#pragma unroll
        for (int j = 0; j < 16; ++j) { const int c = 4 * lane + 256 * j; const f32x4 gg = *(const f32x4*)(g + c), bb = *(const f32x4*)(b + c);
            const f32x4 y = v[j] * rstd * gg + bb; if (OUT_F32) *(f32x4*)(orow + c) = y;
            u32x2 w; w.x = cvtpk(y.x, y.y); w.y = cvtpk(y.z, y.w); *(u32x2*)(hrow + c) = w; }
    } else {
#pragma unroll
        for (int j = 0; j < 8; ++j) { const int c = 8 * lane + 512 * j;
            const f32x4 g0 = *(const f32x4*)(g + c), g1 = *(const f32x4*)(g + c + 4), b0 = *(const f32x4*)(b + c), b1 = *(const f32x4*)(b + c + 4);
            const f32x4 y0 = v[2 * j] * rstd * g0 + b0, y1 = v[2 * j + 1] * rstd * g1 + b1;
            if (OUT_F32) { *(f32x4*)(orow + c) = y0; *(f32x4*)(orow + c + 4) = y1; }
            else { u32x4 w; w.x = cvtpk(y0.x, y0.y); w.y = cvtpk(y0.z, y0.w); w.z = cvtpk(y1.x, y1.y); w.w = cvtpk(y1.z, y1.w); *(u32x4*)(hrow + c) = w; } }
    }
}
template <bool IN_F32, bool OUT_F32>
__device__ __forceinline__ void ln_phase(Frame& F, const float* src, const float* g, const float* b) {
    const int gw = F.vcu * 8 + F.wave, NGW = F.G * 8; bf16* HB = (bf16*)(ws_base() + WS_HB); float* X = x_base();
    int m = gw;
    if (!IN_F32) for (; m + NGW < M; m += 2 * NGW) { const int m2 = m + NGW; f32x4 va[16], vb[16];
        ln_load<IN_F32>(src + (size_t)m * D, HB + (size_t)m * D, va, F.lane); ln_load<IN_F32>(src + (size_t)m2 * D, HB + (size_t)m2 * D, vb, F.lane);
        ln_finish<IN_F32, OUT_F32>(va, g, b, X + (size_t)m * D, HB + (size_t)m * D, F.lane); ln_finish<IN_F32, OUT_F32>(vb, g, b, X + (size_t)m2 * D, HB + (size_t)m2 * D, F.lane); }
    for (; m < M; m += NGW) { f32x4 va[16]; ln_load<IN_F32>(src + (size_t)m * D, HB + (size_t)m * D, va, F.lane); ln_finish<IN_F32, OUT_F32>(va, g, b, X + (size_t)m * D, HB + (size_t)m * D, F.lane); }
}
__device__ __forceinline__ void p0_prologue(Frame& F) {
    const int gw = F.vcu * 8 + F.wave, NGW = F.G * 8, gt = gw * 64 + F.lane, NGT = NGW * 64;
    unsigned char* ws = ws_base();
    for (int i = gt; i < SEQ * 48; i += NGT) {
        const bool isA = i < SEQ * 32; const int j = isA ? i : i - SEQ * 32, nf = isA ? 32 : 16, t = j / nf, f = j - t * nf;
        const double inv = exp(-((double)f / (double)nf) * 9.210340371976184); double s, c; dsincos((double)t * inv, s, c);
        if (isA) { ((float*)(ws + WS_COSA))[j] = (float)c; ((float*)(ws + WS_SINA))[j] = (float)s; } else { ((float*)(ws + WS_COSI))[j] = (float)c; ((float*)(ws + WS_SINI))[j] = (float)s; }
    }
    for (int i = gt; i < 12 * 192; i += NGT) {
        const int h = i / 192, rel = (i - h * 192) - 128, n = rel < 0 ? -rel : rel; int bk = rel > 0 ? 16 : 0;
        if (n < 8) bk += n; else { int lg = 8 + (int)(logf((float)n / 8.f) / 2.772588722239781f * 8.f); if (lg > 15) lg = 15; bk += lg; }
        ((float*)(ws + WS_T5))[i] = inp(I_RELB)[bk * 12 + h] * LOG2E;
    }
    for (int i = gt; i < DEPTH * 4096; i += NGT) {
        const int l = i >> 12, g = (i >> 6) & 63, n = i & 63; double ar, ai, cr, ci; s5_coef(F, l, g, n, ar, ai, cr, ci);
        float* pa = (float*)(ws + WS_S5P + l * S5P_STRIDE + S5P_A) + (g * 64 + n) * 2; pa[0] = (float)ar; pa[1] = (float)ai;
        double pr = ar, pi = ai;
#pragma unroll 1
        for (int k = 0; k < 9; ++k) { const double tr = pr * pr - pi * pi, ti = 2.0 * pr * pi; pr = tr; pi = ti; }
        float* pb = (float*)(ws + WS_S5P + l * S5P_STRIDE + S5P_A512) + (g * 64 + n) * 2; pb[0] = (float)pr; pb[1] = (float)pi;
    }
    for (int i = gt; i < DEPTH * 64 * 8 * 64; i += NGT) {
        const int l = i >> 15, g = (i >> 9) & 63, ct = (i >> 6) & 7, ln = i & 63, oc = ct * 16 + (ln & 15), n = oc & 63, kq = ln >> 4;
        u32x4 o = (u32x4){0u, 0u, 0u, 0u};
        if (kq < 2) { double ar, ai, cr, ci; s5_coef(F, l, g, n, ar, ai, cr, ci); unsigned hv[8];
#pragma unroll
            for (int j = 0; j < 8; ++j) { const int p = 8 * kq + j; const size_t bi = ((size_t)(l * 64 + g) * 64 + n) * 16 + p; const double br = inp(I_BRE)[bi], bim = inp(I_BIM)[bi];
                hv[j] = f2bf((float)(oc < 64 ? cr * br - ci * bim : cr * bim + ci * br)); }
            o.x = hv[0] | (hv[1] << 16); o.y = hv[2] | (hv[3] << 16); o.z = hv[4] | (hv[5] << 16); o.w = hv[6] | (hv[7] << 16); }
        *(u32x4*)(ws + WS_S5P + l * S5P_STRIDE + S5P_BB + ((size_t)(g * 8 + ct) * 64 + ln) * 16) = o;
    }
    for (int i = gt; i < DEPTH * 64 * 4 * 64; i += NGT) {
        const int l = i >> 14, g = (i >> 8) & 63, ks = (i >> 6) & 3, ln = i & 63, p = ln & 15; unsigned hv[8];
#pragma unroll
        for (int j = 0; j < 8; ++j) { const int k = 32 * ks + 8 * (ln >> 4) + j; const size_t ci_ = ((size_t)(l * 64 + g) * 16 + p) * 64 + (k & 63);
            hv[j] = f2bf(k < 64 ? inp(I_CRE)[ci_] : -inp(I_CIM)[ci_]); }
        u32x4 o; o.x = hv[0] | (hv[1] << 16); o.y = hv[2] | (hv[3] << 16); o.z = hv[4] | (hv[5] << 16); o.w = hv[6] | (hv[7] << 16);
        *(u32x4*)(ws + WS_S5P + l * S5P_STRIDE + S5P_CM + ((size_t)(g * 4 + ks) * 64 + ln) * 16) = o;
    }
    for (int i = gt; i < DEPTH * 112 * 512; i += NGT) { const int l = i / (112 * 512), r = i - l * 112 * 512;
        *(u32x4*)(ws + WS_W0 + l * W_LSTRIDE + W_IN + (size_t)NPROJ_USED * D * 2 + (size_t)r * 16) = (u32x4){0u, 0u, 0u, 0u}; }
    LAS float* scr = (LAS float*)(F.lds + F.wave * 16384);
    constexpr int IT_IN = (D / 64) * ((NPROJ_USED + 31) / 32), IT_UQ = (768 / 64) * (2304 / 32), IT_UKV = (512 / 64) * (3072 / 32), IT_GLU = (1024 / 64) * (1024 / 32),
                  IT_OUT = (D / 64) * (D / 32), IT_1 = (D / 64) * (DFF / 32), IT_2 = (DFF / 64) * (D / 32), IT_L = IT_IN + IT_UQ + IT_UKV + IT_GLU + IT_OUT + IT_1 + IT_2;
    for (int it = gw; it < DEPTH * IT_L; it += NGW) {
        const int l = it / IT_L; int r = it - l * IT_L; unsigned char* wl = ws + WS_W0 + l * W_LSTRIDE;
        if (r < IT_IN) { cvt_item<1>(inp(I_WIN) + (size_t)l * D * NPROJ_USED, D, NPROJ_USED, (bf16*)(wl + W_IN), nullptr, scr, r, F.lane); continue; } r -= IT_IN;
        if (r < IT_UQ) { cvt_item<2>(inp(I_AWUQ) + (size_t)l * 768 * 2304, 768, 2304, (bf16*)(wl + W_UQ), inp(I_AGQ) + l * 768, scr, r, F.lane); continue; } r -= IT_UQ;
        if (r < IT_UKV) { cvt_item<0>(inp(I_AWUKV) + (size_t)l * 512 * 3072, 512, 3072, (bf16*)(wl + W_UKV), inp(I_AGKV) + l * 512, scr, r, F.lane); continue; } r -= IT_UKV;
        if (r < IT_GLU) { cvt_item<0>(inp(I_WGLU) + (size_t)l * 1024 * 1024, 1024, 1024, (bf16*)(wl + W_GLU), nullptr, scr, r, F.lane); continue; } r -= IT_GLU;
        if (r < IT_OUT) { cvt_item<0>(inp(I_WOUT) + (size_t)l * D * D, D, D, (bf16*)(wl + W_OUT), nullptr, scr, r, F.lane); continue; } r -= IT_OUT;
        if (r < IT_1) { cvt_item<0>(inp(I_WFF1) + (size_t)l * D * DFF, D, DFF, (bf16*)(wl + W_1), nullptr, scr, r, F.lane); continue; } r -= IT_1;
        cvt_item<0>(inp(I_WFF2) + (size_t)l * DFF * D, DFF, D, (bf16*)(wl + W_2), nullptr, scr, r, F.lane);
    }
    ln_phase<true, false>(F, inp(I_X), inp(I_LNG), inp(I_LNB));
}
constexpr int S5_WLDS = 8192 + 16 * 272;
template <bool OUT>
__device__ __forceinline__ void s5_task(Frame& F, int layer, int b, int g, int o, LAS unsigned char* wl) {
    const int lane = F.lane, kq = lane >> 4, p = lane & 15;
    const unsigned char* sp = ws_base() + WS_S5P + layer * S5P_STRIDE;
    const float ar = ((const float*)(sp + S5P_A))[(g * 64 + lane) * 2], ai = ((const float*)(sp + S5P_A))[(g * 64 + lane) * 2 + 1];
    bf16x8 bbf[8];
#pragma unroll
    for (int ct = 0; ct < 8; ++ct) bbf[ct] = *(const bf16x8*)(sp + S5P_BB + ((size_t)(g * 8 + ct) * 64 + lane) * 16);
    bf16x8 cmf[4]; float dsk = 0.f;
    float* E = (float*)(ws_base() + WS_E);
    float hr = 0.f, hi = 0.f;
    if (OUT) {
#pragma unroll
        for (int ks = 0; ks < 4; ++ks) cmf[ks] = *(const bf16x8*)(sp + S5P_CM + ((size_t)(g * 4 + ks) * 64 + lane) * 16);
        dsk = inp(I_SD)[(layer * 64 + g) * 16 + p];
        const float pr = ((const float*)(sp + S5P_A512))[(g * 64 + lane) * 2], pi = ((const float*)(sp + S5P_A512))[(g * 64 + lane) * 2 + 1];
        for (int oo = 0; oo < o; ++oo) { const float er = E[((size_t)(b * 64 + g) * 8 + oo) * 128 + lane], ei = E[((size_t)(b * 64 + g) * 8 + oo) * 128 + 64 + lane];
            const float nr = pr * hr - pi * hi + er, ni = pr * hi + pi * hr + ei; hr = nr; hi = ni; }
    }
    LAS float* BUf = (LAS float*)wl; LAS unsigned short* Hs = (LAS unsigned short*)(wl + 8192);
    const bf16* PROJ = (const bf16*)(ws_base() + WS_PROJ); bf16* G = (bf16*)(ws_base() + WS_G);
    const size_t r0 = (size_t)b * SEQ + (size_t)o * 512;
    const bf16* up = PROJ + (r0 + p) * NPROJ + C_USSM + 16 * g + 8 * (kq & 1);
    bf16x8 nxt = (bf16x8){0, 0, 0, 0, 0, 0, 0, 0}, nx2 = nxt;
    if (kq < 2) { nxt = *(const bf16x8*)up; nx2 = *(const bf16x8*)(up + (size_t)16 * NPROJ); }
    const bf16* ue = PROJ + (r0 + 4 * kq) * NPROJ + C_USSM + 16 * g + p;
    unsigned short un[4] = {0, 0, 0, 0};
    if (OUT) {
#pragma unroll
        for (int r = 0; r < 4; ++r) un[r] = ue[(size_t)r * NPROJ];
    }
    for (int it = 0; it < 32; ++it) {
        const bf16x8 cur = nxt; nxt = nx2;
        if (it + 2 < 32 && kq < 2) nx2 = *(const bf16x8*)(up + (size_t)(it + 2) * 16 * NPROJ);
        unsigned short uc[4];
#pragma unroll
        for (int r = 0; r < 4; ++r) uc[r] = un[r];
        if (OUT && it + 1 < 32) {
#pragma unroll
            for (int r = 0; r < 4; ++r) un[r] = ue[(size_t)((it + 1) * 16 + r) * NPROJ];
        }
#pragma unroll
        for (int ct = 0; ct < 8; ++ct) { const f32x4 c = __builtin_amdgcn_mfma_f32_16x16x32_bf16(cur, bbf[ct], (f32x4){0.f, 0.f, 0.f, 0.f}, 0, 0, 0);
#pragma unroll
            for (int r = 0; r < 4; ++r) BUf[(kq * 4 + r) * 128 + ct * 16 + p] = c[r]; }
        asm volatile("" ::: "memory");
#pragma unroll
        for (int ps = 0; ps < 16; ++ps) { const float br = BUf[ps * 128 + lane], bi = BUf[ps * 128 + 64 + lane];
            const float nr = ar * hr - ai * hi + br, ni = ar * hi + ai * hr + bi; hr = nr; hi = ni;
            if (OUT) { Hs[ps * 136 + lane] = (unsigned short)f2bf(hr); Hs[ps * 136 + 64 + lane] = (unsigned short)f2bf(hi); } }
        asm volatile("" ::: "memory");
        if (OUT) {
            f32x4 y = (f32x4){0.f, 0.f, 0.f, 0.f};
#pragma unroll
            for (int ks = 0; ks < 4; ++ks) { const bf16x8 a = *(const LAS bf16x8*)(Hs + p * 136 + 32 * ks + 8 * kq); y = __builtin_amdgcn_mfma_f32_16x16x32_bf16(a, cmf[ks], y, 0, 0, 0); }
#pragma unroll
            for (int r = 0; r < 4; ++r) { const size_t row = r0 + it * 16 + kq * 4 + r; const float u = bf2f(uc[r]);
                const float v = y[r] + dsk * u, z = 0.7978845608028654f * (v + 0.044715f * v * v * v);
                G[row * 1024 + 16 * g + p] = (bf16)f2bf(v / (1.f + __expf(-2.f * z))); }
            asm volatile("" ::: "memory");
        }
    }
    if (!OUT) { E[((size_t)(b * 64 + g) * 8 + o) * 128 + lane] = hr; E[((size_t)(b * 64 + g) * 8 + o) * 128 + 64 + lane] = hi; }
}
template <bool OUT>
__device__ __forceinline__ void s5_phase(Frame& F, int layer) {
    const int gw = F.vcu * 8 + F.wave, NGW = F.G * 8;
    LAS unsigned char* wl = F.lds + F.wave * S5_WLDS;
    for (int task = gw; task < NB * 64 * 8; task += NGW) { const int o = task & 7, g = (task >> 3) & 63, b = task >> 9;
        if (!OUT && o == 7) continue;
        s5_task<OUT>(F, layer, b, g, o, wl); }
}

__device__ __forceinline__ float relu1(float x) { const int i = __builtin_bit_cast(int, x); return __builtin_bit_cast(float, i > 0 ? i : 0); }
template <bool PROBE> __device__ __forceinline__ void dsa_index_phase(Frame& F, int qword, unsigned long long& pacc) {
    const int lane = F.lane, wave = F.wave, r32 = lane & 31, hi = lane >> 5;
    const bf16* PROJ = (const bf16*)(ws_base() + WS_PROJ); u64* MASK = (u64*)(ws_base() + WS_MASK);
    LAS unsigned* sc = (LAS unsigned*)F.lds;
    volatile LAS unsigned* qs = (volatile LAS unsigned*)(F.lds + LDSCTL_OFF + 64);
    for (;;) {
        if (F.tid == 0) qs[0] = __hip_atomic_fetch_add(ctl_base() + CW_Q + 64 * qword, 1u, RLX_AGENT);
        __syncthreads();
        const unsigned idx = qs[0];
        __syncthreads();
        if (idx >= 2048u) break;
        const int t0 = 4088 - 8 * (int)(idx >> 2), b = (int)(idx & 3u), lim = 64 * ((t0 >> 6) + 1), nk64 = lim >> 6;
        const size_t rowq = (size_t)b * SEQ + t0;
        if (lim <= 256) { MASK[(rowq + wave) * 64 + lane] = lane < nk64 ? ~0ull : 0ull; continue; }
#pragma unroll 1
        for (int hb = 0; hb < 2; ++hb) {
            bf16x8 afr[2][4]; float wq[2][16];
#pragma unroll
            for (int bl = 0; bl < 2; ++bl)
#pragma unroll
                for (int ks = 0; ks < 4; ++ks) afr[bl][ks] = *(const bf16x8*)(PROJ + (rowq + 4 * hb + 2 * bl + (r32 >> 4)) * NPROJ + C_QI + (r32 & 15) * 64 + ks * 16 + 8 * hi);
#pragma unroll
            for (int bl = 0; bl < 2; ++bl)
#pragma unroll
                for (int r = 0; r < 16; ++r) wq[bl][r] = bf2f(PROJ[(rowq + 4 * hb + 2 * bl + (r >> 3)) * NPROJ + C_WI + (r & 3) + 8 * ((r >> 2) & 1) + 4 * hi]);
            const int ntile = lim >> 5;
            const bf16* kp = PROJ + ((size_t)b * SEQ + r32) * NPROJ + C_KI + 8 * hi;
            bf16x8 bn[4];
            if (wave < ntile) {
#pragma unroll
                for (int ks = 0; ks < 4; ++ks) bn[ks] = *(const bf16x8*)(kp + (size_t)wave * 32 * NPROJ + ks * 16);
            }
            for (int kt = wave; kt < ntile; kt += 8) {
                bf16x8 bc[4];
#pragma unroll
                for (int ks = 0; ks < 4; ++ks) bc[ks] = bn[ks];
                if (kt + 8 < ntile) {
#pragma unroll
                    for (int ks = 0; ks < 4; ++ks) bn[ks] = *(const bf16x8*)(kp + (size_t)(kt + 8) * 32 * NPROJ + ks * 16);
                }
#pragma unroll
                for (int bl = 0; bl < 2; ++bl) {
                    f32x16 c = {};
#pragma unroll
                    for (int ks = 0; ks < 4; ++ks) c = __builtin_amdgcn_mfma_f32_32x32x16_bf16(afr[bl][ks], bc[ks], c, 0, 0, 0);
                    float sA = 0.f, sB = 0.f;
#pragma unroll
                    for (int r = 0; r < 8; ++r) { sA = __builtin_fmaf(relu1(c[r]), wq[bl][r], sA); sB = __builtin_fmaf(relu1(c[8 + r]), wq[bl][8 + r], sB); }
                    auto rr = __builtin_amdgcn_permlane32_swap(__float_as_uint(sA), __float_as_uint(sB), false, false);
                    const float tot = __uint_as_float(rr[0]) + __uint_as_float(rr[1]);
                    unsigned ub = __float_as_uint(tot); ub = (ub & 0x80000000u) ? ~ub : (ub | 0x80000000u);
                    sc[(4 * hb + 2 * bl + hi) * 4096 + kt * 32 + r32] = ub;
                }
            }
        }
        __syncthreads();
        unsigned long long ps0_ = 0ull; if (PROBE) ps0_ = __builtin_amdgcn_s_memrealtime();
        {
            unsigned kv[64];
#pragma unroll
            for (int i = 0; i < 64; ++i) { const unsigned v = sc[wave * 4096 + i * 64 + lane]; kv[i] = i < nk64 ? v : 0u; }
            LAS unsigned* hist = (LAS unsigned*)(F.lds + LDSCTL_OFF + 1024 + wave * 1024);
            unsigned T = 0u;
#pragma unroll 1
            for (int bit = 31; bit >= 23; --bit) {
                const unsigned cand = T | (1u << bit); int cnt = 0;
#pragma unroll
                for (int i = 0; i < 64; ++i) cnt += (kv[i] >= cand) ? 1 : 0;
#pragma unroll
                for (int o = 1; o < 64; o <<= 1) cnt += __shfl_xor(cnt, o);
                T = cnt >= 256 ? cand : T;
            }
            int need;
            { int cab = 0; const unsigned nxt = T + (1u << 23);
              if (nxt > T) {
#pragma unroll
                  for (int i = 0; i < 64; ++i) cab += (kv[i] >= nxt) ? 1 : 0;
#pragma unroll
                  for (int o = 1; o < 64; o <<= 1) cab += __shfl_xor(cab, o); }
              need = __builtin_amdgcn_readfirstlane(256 - cab); }
#pragma unroll 1
            for (int pass = 0; pass < 3; ++pass) {
                const int shift = pass == 0 ? 15 : pass == 1 ? 7 : 0, nb = pass == 2 ? 7 : 8; const unsigned dm = (1u << nb) - 1u;
                *(LAS u32x4*)(hist + 4 * lane) = (u32x4){0u, 0u, 0u, 0u};
                const unsigned pfx = T >> (shift + nb);
#pragma unroll
                for (int i = 0; i < 64; ++i) { if (i < nk64) { const unsigned k = kv[i];
                    if ((k >> (shift + nb)) == pfx) (void)__hip_atomic_fetch_add(hist + ((k >> shift) & dm), 1u, __ATOMIC_RELAXED, __HIP_MEMORY_SCOPE_WORKGROUP); } }
                asm volatile("s_waitcnt lgkmcnt(0)" ::: "memory");
                const u32x4 hc = *(const LAS u32x4*)(hist + 4 * lane);
                const int sl = (int)(hc.x + hc.y + hc.z + hc.w); int suf = sl;
#pragma unroll
                for (int d = 1; d < 64; d <<= 1) { const int v = __shfl_down(suf, d); if (lane + d < 64) suf += v; }
                const int above = suf - sl;
                const int s3 = above + (int)hc.w, s2 = s3 + (int)hc.z, s1 = s2 + (int)hc.y, s0 = s1 + (int)hc.x;
                int dloc = -1, nloc = 0;
                if (s3 >= need && above < need) { dloc = 3; nloc = need - above; }
                else if (s2 >= need && s3 < need) { dloc = 2; nloc = need - s3; }
                else if (s1 >= need && s2 < need) { dloc = 1; nloc = need - s2; }
                else if (s0 >= need && s1 < need) { dloc = 0; nloc = need - s1; }
                const u64 fm = __ballot(dloc >= 0); const int src = fm ? __builtin_ctzll(fm) : 0;
                const int dstar = 4 * src + __builtin_amdgcn_readlane(dloc, src); need = __builtin_amdgcn_readlane(nloc, src);
                T |= (unsigned)dstar << shift;
                asm volatile("" ::: "memory");
            }
            int eqt = 0;
#pragma unroll
            for (int i = 0; i < 64; ++i) eqt += (kv[i] == T) ? 1 : 0;
#pragma unroll
            for (int o = 1; o < 64; o <<= 1) eqt += __shfl_xor(eqt, o);
            eqt = __builtin_amdgcn_readfirstlane(eqt);
            unsigned mlo = 0u, mhi = 0u;
            if (eqt == need) {
#define WL1(I) { const u64 w = __ballot(kv[I] >= T); const unsigned wl_ = (unsigned)w, wh_ = (unsigned)(w >> 32); \
                    asm volatile("s_nop 3\n\tv_writelane_b32 %0, %2, %4\n\tv_writelane_b32 %1, %3, %4" : "+v"(mlo), "+v"(mhi) : "s"(wl_), "s"(wh_), "n"(I)); }
#define WL4(I) WL1(I) WL1(I + 1) WL1(I + 2) WL1(I + 3)
#define WL16(I) WL4(I) WL4(I + 4) WL4(I + 8) WL4(I + 12)
                WL16(0) WL16(16) WL16(32) WL16(48)
#undef WL16
#undef WL4
#undef WL1
            } else {
                int nd = need;
#pragma unroll 1
                for (int i = 0; i < 64; ++i) {
                    unsigned kvi = 0u;
#pragma unroll
                    for (int j2 = 0; j2 < 64; ++j2) kvi = (j2 == i) ? kv[j2] : kvi;
                    u64 eq = __ballot(kvi == T); const u64 g1 = __ballot(kvi > T);
                    const int ce = __builtin_popcountll(eq);
                    if (ce > nd) { u64 tt = eq, kept = 0ull; for (int c = 0; c < nd; ++c) { const u64 low = tt & (0ull - tt); kept |= low; tt ^= low; } eq = kept; nd = 0; }
                    else nd -= ce;
                    const u64 w = g1 | eq;
                    if (lane == i) { mlo = (unsigned)w; mhi = (unsigned)(w >> 32); }
                }
            }
            const u64 mine = ((u64)mhi << 32) | mlo;
            MASK[(rowq + wave) * 64 + lane] = mine;
        }
        __syncthreads();
        if (PROBE) pacc += __builtin_amdgcn_s_memrealtime() - ps0_;
    }
}
namespace fa {
constexpr int SHM_V = 16384, DQK = 192, SHM_K = 64 * DQK * 2;
#define KSWZ(row, colB) ((row) * 256 + ((colB) ^ (((row) & 7) << 4)))
#define SBAR() __builtin_amdgcn_sched_barrier(0)
#define FA_BAR() asm volatile("s_waitcnt lgkmcnt(0)\n\ts_barrier" ::: "memory")
__device__ __forceinline__ int v_st(int k, int c) { const int kk = (k & ~0xC) | ((k & 4) << 1) | ((k & 8) >> 1); return ((kk >> 3) * 4 + (c >> 5)) * 512 + ((kk & 7) * 32 + (c & 31)) * 2; }
__device__ __forceinline__ int v_rd_base(int lane) { return ((lane & 3) << 3) | (((lane >> 2) & 3) << 6) | (((lane >> 4) & 1) << 5) | (((lane >> 5) & 1) << 8); }
constexpr int v_rd_off(int d0, int ks, int half) { return d0 * 512 + ks * 4096 + half * 2048; }
__device__ __forceinline__ int crow(int r, int hi) { return (r & 3) + 8 * (r >> 2) + 4 * hi; }
struct Args {
    const bf16* Q; int ldq; const bf16* Qr;
    const bf16* K; int ldk; const bf16* Kr; int ldkr; const bf16* V; int ldv;
    bf16* O; int ldo;
};
struct State { bf16x8 qr[DQK / 16]; f32x16 o[4]; f32x16 p0, p1; float m, l; bf16x8 sk0, sk1, sv0, sv1, skr; };

__device__ __forceinline__ void stage_load(const Args& A, State& S, int t1, int tid) {
    int tid2 = tid; asm volatile("" : "+v"(tid2));
    const int sr = tid2 >> 4, scc = (tid2 & 15) * 8; const size_t k1 = (size_t)t1 * 64;
    S.sv0 = *(const bf16x8*)(A.V + (k1 + sr) * A.ldv + scc); S.sv1 = *(const bf16x8*)(A.V + (k1 + 32 + sr) * A.ldv + scc);
    S.sk0 = *(const bf16x8*)(A.K + (k1 + sr) * A.ldk + scc); S.sk1 = *(const bf16x8*)(A.K + (k1 + 32 + sr) * A.ldk + scc);
    S.skr = *(const bf16x8*)(A.Kr + (k1 + (tid2 >> 3)) * A.ldkr + (tid2 & 7) * 8);
}
template <int NB_>
__device__ __forceinline__ void stage_write(State& S, char* lds, int tid) {
    int tid2 = tid; asm volatile("" : "+v"(tid2));
    const int sr = tid2 >> 4, scc = (tid2 & 15) * 8, kws = KSWZ(sr, scc * 2), rr_ = tid2 >> 3;
    char* V_lds = lds; char* K_lds = lds + 2 * SHM_V;
    asm volatile("s_waitcnt vmcnt(0)" ::: "memory");
    *(bf16x8*)(V_lds + NB_ * SHM_V + v_st(sr, scc)) = S.sv0; *(bf16x8*)(V_lds + NB_ * SHM_V + v_st(32 + sr, scc)) = S.sv1;
    *(bf16x8*)(K_lds + NB_ * SHM_K + kws) = S.sk0; *(bf16x8*)(K_lds + NB_ * SHM_K + kws + 32 * 256) = S.sk1;
    *(bf16x8*)(K_lds + NB_ * SHM_K + 16384 + rr_ * 128 + (((tid2 & 7) * 16) ^ ((rr_ & 7) << 4))) = S.skr;
}
template <int BUF>
__device__ __forceinline__ void seg_qk(State& S, char* lds, int tid) {
    const int lane = tid & 63, r32 = lane & 31, hi = lane >> 5;
    char* K_lds = lds + 2 * SHM_V;
    f32x16 p0 = {}, p1 = {};
    const char* kb[4];
#pragma unroll
    for (int dd = 0; dd < 4; ++dd) kb[dd] = K_lds + BUF * SHM_K + KSWZ(r32, (dd * 16 + hi * 8) * 2);
#pragma unroll
    for (int d0 = 0; d0 < 8; ++d0) { const char* a = kb[d0 & 3] + (d0 >> 2) * 128;
        const bf16x8 b0 = *(const bf16x8*)a, b1 = *(const bf16x8*)(a + 32 * 256);
        p0 = __builtin_amdgcn_mfma_f32_32x32x16_bf16(b0, S.qr[d0], p0, 0, 0, 0); p1 = __builtin_amdgcn_mfma_f32_32x32x16_bf16(b1, S.qr[d0], p1, 0, 0, 0); }
#pragma unroll
    for (int d0 = 0; d0 < 4; ++d0) { const char* a = K_lds + BUF * SHM_K + 16384 + r32 * 128 + ((d0 * 32 + hi * 16) ^ ((r32 & 7) << 4));
        const bf16x8 b0 = *(const bf16x8*)a, b1 = *(const bf16x8*)(a + 32 * 128);
        p0 = __builtin_amdgcn_mfma_f32_32x32x16_bf16(b0, S.qr[8 + d0], p0, 0, 0, 0); p1 = __builtin_amdgcn_mfma_f32_32x32x16_bf16(b1, S.qr[8 + d0], p1, 0, 0, 0); }
    S.p0 = p0; S.p1 = p1;
}
template <int BUF>
__device__ __forceinline__ void seg_pv(State& S, char* lds, int tid) {
    const int wid = __builtin_amdgcn_readfirstlane(tid >> 6), lane = tid & 63, r32 = lane & 31, hi = lane >> 5;
    char* V_lds = lds;
    float* wsf = (float*)(lds + 2 * SHM_V + 2 * SHM_K) + wid * 64; float* al_l = wsf + 32;
    f32x16 p0 = S.p0, p1 = S.p1;
    float pmax = p0[0];
#pragma unroll
    for (int r = 1; r < 16; ++r) pmax = fmaxf(pmax, p0[r]);
#pragma unroll
    for (int r = 0; r < 16; ++r) pmax = fmaxf(pmax, p1[r]);
    { auto rr = __builtin_amdgcn_permlane32_swap(__float_as_uint(pmax), __float_as_uint(pmax), false, false); pmax = fmaxf(__uint_as_float(rr[0]), __uint_as_float(rr[1])); }
    float alpha = 1.f;
    if (!__all(pmax - S.m <= 8.f)) { const float mn = fmaxf(S.m, pmax); alpha = __builtin_amdgcn_exp2f(S.m - mn); S.m = mn; }
    const float mcur = S.m;
#pragma unroll
    for (int r = 0; r < 16; ++r) { p0[r] = __builtin_amdgcn_exp2f(p0[r] - mcur); p1[r] = __builtin_amdgcn_exp2f(p1[r] - mcur); }
    float ps = 0.f;
#pragma unroll
    for (int r = 0; r < 16; ++r) ps += p0[r] + p1[r];
    { auto rr = __builtin_amdgcn_permlane32_swap(__float_as_uint(ps), __float_as_uint(ps), false, false); ps = __uint_as_float(rr[0]) + __uint_as_float(rr[1]); }
    S.l = S.l * alpha + ps;
    bf16x8 pa0, pa1, pa2, pa3;
#define PK4(P, B_, OUT) do { unsigned a0 = cvtpk(P[B_+0], P[B_+1]), a1 = cvtpk(P[B_+2], P[B_+3]); unsigned b0 = cvtpk(P[B_+4], P[B_+5]), b1 = cvtpk(P[B_+6], P[B_+7]); \
    auto r0 = __builtin_amdgcn_permlane32_swap(a0, b0, false, false); auto r1 = __builtin_amdgcn_permlane32_swap(a1, b1, false, false); \
    u32x4 w = {r0[0], r1[0], r0[1], r1[1]}; OUT = __builtin_bit_cast(bf16x8, w); } while (0)
    PK4(p0, 0, pa0); PK4(p0, 8, pa1); PK4(p1, 0, pa2); PK4(p1, 8, pa3);
#undef PK4
    if (__any(alpha < 1.f)) { if (hi == 0) al_l[r32] = alpha; asm volatile("s_waitcnt lgkmcnt(0)" ::: "memory");
#pragma unroll
        for (int d_ = 0; d_ < 4; ++d_)
#pragma unroll
            for (int r = 0; r < 16; ++r) S.o[d_][r] *= al_l[crow(r, hi)]; }
    const int vb0 = (int)(uintptr_t)V_lds + v_rd_base(lane);
#define TRRD(dst, off) asm volatile("ds_read_b64_tr_b16 %0, %1 offset:%2" : "=&v"(dst) : "v"(vb0), "i"(off) : "memory")
#define PV_D0(d0) do { s16x4 l0, l1, l2, l3, h0, h1, h2, h3; constexpr int b_ = BUF * SHM_V + v_rd_off(d0, 0, 0); \
    TRRD(l0, b_); TRRD(h0, b_ + 2048); TRRD(l1, b_ + 4096); TRRD(h1, b_ + 6144); TRRD(l2, b_ + 8192); TRRD(h2, b_ + 10240); TRRD(l3, b_ + 12288); TRRD(h3, b_ + 14336); \
    asm volatile("s_waitcnt lgkmcnt(0)" ::: "memory"); SBAR(); \
    S.o[d0] = __builtin_amdgcn_mfma_f32_32x32x16_bf16(pa0, (bf16x8){l0[0], l0[1], l0[2], l0[3], h0[0], h0[1], h0[2], h0[3]}, S.o[d0], 0, 0, 0); \
    S.o[d0] = __builtin_amdgcn_mfma_f32_32x32x16_bf16(pa1, (bf16x8){l1[0], l1[1], l1[2], l1[3], h1[0], h1[1], h1[2], h1[3]}, S.o[d0], 0, 0, 0); \
    S.o[d0] = __builtin_amdgcn_mfma_f32_32x32x16_bf16(pa2, (bf16x8){l2[0], l2[1], l2[2], l2[3], h2[0], h2[1], h2[2], h2[3]}, S.o[d0], 0, 0, 0); \
    S.o[d0] = __builtin_amdgcn_mfma_f32_32x32x16_bf16(pa3, (bf16x8){l3[0], l3[1], l3[2], l3[3], h3[0], h3[1], h3[2], h3[3]}, S.o[d0], 0, 0, 0); } while (0)
    PV_D0(0); PV_D0(1); PV_D0(2); PV_D0(3);
#undef PV_D0
#undef TRRD
}
template <int BUF>
__device__ __forceinline__ void tile(const Args& A, State& S, int t, int NT, int my_last, int hb, char* lds, int tid) {
    const bool act = t <= my_last;
    if (hb == 0 && t + 1 < NT) stage_load(A, S, t + 1, tid);
    if (act) seg_qk<BUF>(S, lds, tid);
    if (hb == 1 && t + 1 < NT) stage_write<BUF ^ 1>(S, lds, tid);
    FA_BAR();
    if (hb == 1 && t + 2 < NT) stage_load(A, S, t + 2, tid);
    if (act) seg_pv<BUF>(S, lds, tid);
    if (hb == 0 && t + 1 < NT) stage_write<BUF ^ 1>(S, lds, tid);
    FA_BAR();
}
__device__ __forceinline__ void unit(const Args& A, int qb, char* lds) {
    int tid_ = threadIdx.x; asm volatile("" : "+v"(tid_));
    const int tid = tid_, wid = __builtin_amdgcn_readfirstlane(tid >> 6), lane = tid & 63, r32 = lane & 31, hi = lane >> 5, hb = wid >> 2;
    const int q0 = qb * 256, NT = 4 * qb + 4, my_last = 4 * qb + (wid >> 1);
    float* wsf = (float*)(lds + 2 * SHM_V + 2 * SHM_K) + wid * 64;
    State S;
    const bf16* qp = A.Q + (size_t)(q0 + wid * 32 + r32) * A.ldq + hi * 8;
#pragma unroll
    for (int d0 = 0; d0 < 8; ++d0) S.qr[d0] = *(const bf16x8*)(qp + d0 * 16);
    { const bf16* qrp = A.Qr + (size_t)(q0 + wid * 32 + r32) * A.ldq + hi * 8;
#pragma unroll
      for (int d0 = 0; d0 < 4; ++d0) S.qr[8 + d0] = *(const bf16x8*)(qrp + d0 * 16); }
    S.m = -1e30f; S.l = 0.f;
#pragma unroll
    for (int d = 0; d < 4; ++d) S.o[d] = f32x16{};
    stage_load(A, S, 0, tid); stage_write<0>(S, lds, tid);
    __syncthreads();
    if (hb == 1) { stage_load(A, S, 1, tid); FA_BAR(); }
    for (int t = 0; t < NT; t += 2) { tile<0>(A, S, t, NT, my_last, hb, lds, tid); tile<1>(A, S, t + 1, NT, my_last, hb, lds, tid); }
    if (hb == 0) FA_BAR();
    float* li_l = wsf;
    if (hi == 0) li_l[r32] = S.l; asm volatile("s_waitcnt lgkmcnt(0)" ::: "memory");
    float rli[16];
#pragma unroll
    for (int r = 0; r < 16; ++r) rli[r] = __builtin_amdgcn_rcpf(li_l[crow(r, hi)]);
    bf16* Ow = A.O + (size_t)(q0 + wid * 32) * A.ldo;
#pragma unroll
    for (int r = 0; r < 16; ++r) { const int orow = crow(r, hi);
#pragma unroll
        for (int d0 = 0; d0 < 4; ++d0) { const float v = S.o[d0][r] * rli[r]; const float vn = __shfl_xor(v, 1);
            if ((r32 & 1) == 0) *(unsigned*)(Ow + (size_t)orow * A.ldo + d0 * 32 + r32) = cvtpk(v, vn); } }
    __syncthreads();
}
#undef KSWZ
#undef SBAR
#undef FA_BAR
}

__device__ const unsigned char MLA_ORDER[96] = {120, 121, 122, 123, 124, 125, 112, 113, 114, 115, 116, 117, 104, 105, 106, 107, 108, 109, 96, 97, 98, 99, 100, 101, 88, 89, 90, 91, 92, 93, 80, 81, 82, 72, 83, 73, 84, 74, 75, 48, 85, 49, 76, 50, 77, 40, 56, 51, 52, 41, 53, 42, 64, 57, 65, 58, 66, 43, 67, 59, 68, 60, 69, 61, 44, 45, 32, 33, 34, 35, 24, 25, 36, 37, 26, 27, 16, 17, 28, 29, 8, 9, 18, 19, 20, 21, 0, 1, 2, 10, 11, 12, 13, 3, 4, 5};
__device__ __forceinline__ void attn_phase(Frame& F, int qbase) {
    volatile LAS unsigned* qs = (volatile LAS unsigned*)(F.lds + LDSCTL_OFF + 64);
    const bf16* PROJ = (const bf16*)(ws_base() + WS_PROJ); const bf16* QA = (const bf16*)(ws_base() + WS_QA); const bf16* KV = (const bf16*)(ws_base() + WS_KV); bf16* MIX = (bf16*)(ws_base() + WS_MIX);
    int x = (int)((unsigned)__builtin_amdgcn_s_getreg((3 << 11) | 20) & 7u), tries = 0;
    while (tries < 8) {
        if (F.tid == 0) qs[0] = __hip_atomic_fetch_add(ctl_base() + CW_Q + 64 * (qbase + x), 1u, RLX_AGENT);
        __syncthreads();
        const unsigned idx = qs[0];
        __syncthreads();
        if (idx >= 96u) { x = (x + 1) & 7; ++tries; continue; }
        const int ent = MLA_ORDER[idx], bh = x * 6 + (ent & 7), qb = ent >> 3, b = bh / 12, h = bh - b * 12;
        const size_t rb = (size_t)b * SEQ;
        fa::Args A;
        A.Q = QA + rb * NQA + h * 128; A.ldq = NQA; A.Qr = QA + rb * NQA + 1536 + h * 64; A.K = KV + rb * NKV + h * 256; A.ldk = NKV; A.Kr = PROJ + rb * NPROJ + C_KROPE; A.ldkr = NPROJ;
        A.V = KV + rb * NKV + h * 256 + 128; A.ldv = NKV; A.O = MIX + rb * D + h * 128; A.ldo = D;
        fa::unit(A, qb, (char*)F.lds);
    }
}
namespace dg {
constexpr int WLDS = 9216;
constexpr int T5_OFF = 8 * WLDS;
__device__ __forceinline__ int voff(int row, int ch) { return 256 * row + 16 * (ch ^ (((row & 3) << 2) | ((row >> 2) & 3))); }
__device__ __forceinline__ void query(const bf16* PROJ, const u64* MASK, bf16* MIX, int b, int t, LAS unsigned char* wl, const LAS float* t5l, int lane) {
    const int kq = lane >> 4, c16 = lane & 15;
    LAS unsigned short* list = (LAS unsigned short*)wl; LAS unsigned char* vt = wl + 1024;
    const size_t rowb = (size_t)b * SEQ;
    int nsel;
    { const u64 w = MASK[(rowb + t) * 64 + lane]; const int cnt = __builtin_popcountll(w); int inc = cnt;
#pragma unroll
      for (int d = 1; d < 64; d <<= 1) { const int v = __shfl_up(inc, d); if (lane >= d) inc += v; }
      int off = inc - cnt; nsel = __shfl(inc, 63);
      u64 ww = w; while (ww) { const int bp = __builtin_ctzll(ww); list[off++] = (unsigned short)(lane * 64 + bp); ww &= ww - 1; }
      for (int p = nsel + lane; p < 256; p += 64) list[p] = 0; }
    asm volatile("s_waitcnt lgkmcnt(0)" ::: "memory");
    bf16x8 qf[4];
#pragma unroll
    for (int ks = 0; ks < 4; ++ks) { qf[ks] = (bf16x8){0, 0, 0, 0, 0, 0, 0, 0}; if (c16 < 12) qf[ks] = *(const bf16x8*)(PROJ + (rowb + t) * NPROJ + C_QC + c16 * 128 + 32 * ks + 8 * kq); }
    f32x4 st[16];
    const bf16* kbase = PROJ + rowb * NPROJ + C_KC + 8 * kq;
    bf16x8 kb[4][4];
#pragma unroll
    for (int T = 0; T < 4; ++T) { const unsigned ki = list[T * 16 + c16];
#pragma unroll
        for (int ks = 0; ks < 4; ++ks) kb[T][ks] = *(const bf16x8*)(kbase + (size_t)ki * NPROJ + 32 * ks); }
#pragma unroll
    for (int T = 0; T < 16; ++T) {
        f32x4 c = (f32x4){0.f, 0.f, 0.f, 0.f};
#pragma unroll
        for (int ks = 0; ks < 4; ++ks) c = __builtin_amdgcn_mfma_f32_16x16x32_bf16(kb[T & 3][ks], qf[ks], c, 0, 0, 0);
        st[T] = c;
        if (T + 4 < 16) { const unsigned ki = list[(T + 4) * 16 + c16];
#pragma unroll
            for (int ks = 0; ks < 4; ++ks) kb[T & 3][ks] = *(const bf16x8*)(kbase + (size_t)ki * NPROJ + 32 * ks); }
    }
    const LAS float* tb = t5l + (c16 < 12 ? c16 : 0) * 192 + 128 - t;
    float mx = -__builtin_inff();
#pragma unroll
    for (int T = 0; T < 16; ++T) { const u32x2 iw = *(const LAS u32x2*)(list + T * 16 + 4 * kq);
#pragma unroll
        for (int r = 0; r < 4; ++r) { const int ki = (int)((r & 1) ? (iw[r >> 1] >> 16) : (iw[r >> 1] & 0xffffu)); int rel = ki - t; rel = rel < -128 ? -128 : rel;
            float s = st[T][r] + tb[t + rel]; if (T * 16 + 4 * kq + r >= nsel) s = -__builtin_inff(); st[T][r] = s; mx = fmaxf(mx, s); } }
    mx = fmaxf(mx, __shfl_xor(mx, 16)); mx = fmaxf(mx, __shfl_xor(mx, 32));
    float sum = 0.f;
#pragma unroll
    for (int T = 0; T < 16; ++T)
#pragma unroll
        for (int r = 0; r < 4; ++r) { const float p = __builtin_amdgcn_exp2f(st[T][r] - mx); st[T][r] = p; sum += p; }
    sum += __shfl_xor(sum, 16); sum += __shfl_xor(sum, 32);
    bf16x8 pf[8];
#pragma unroll
    for (int s = 0; s < 8; ++s) { u32x4 w; w.x = cvtpk(st[2 * s][0], st[2 * s][1]); w.y = cvtpk(st[2 * s][2], st[2 * s][3]); w.z = cvtpk(st[2 * s + 1][0], st[2 * s + 1][1]); w.w = cvtpk(st[2 * s + 1][2], st[2 * s + 1][3]);
        pf[s] = __builtin_bit_cast(bf16x8, w); }
    f32x4 o[8];
#pragma unroll
    for (int dt = 0; dt < 8; ++dt) o[dt] = (f32x4){0.f, 0.f, 0.f, 0.f};
    const bf16* vbase = PROJ + rowb * NPROJ + C_VC + 8 * c16;
    u32x4 vn[2][8];
#pragma unroll
    for (int s = 0; s < 2; ++s)
#pragma unroll
        for (int i = 0; i < 8; ++i) { const int rho = kq + 4 * i; const unsigned vi = list[(2 * s + ((rho >> 2) & 1)) * 16 + 4 * (rho >> 3) + (rho & 3)]; vn[s][i] = *(const u32x4*)(vbase + (size_t)vi * NPROJ); }
    const int q4 = c16 >> 2, p4 = c16 & 3;
    const int vtb = (int)(uintptr_t)vt;
#pragma unroll
    for (int s = 0; s < 8; ++s) {
#pragma unroll
        for (int i = 0; i < 8; ++i) { const int rho = kq + 4 * i; *(LAS u32x4*)(vt + voff(rho, c16)) = vn[s & 1][i]; }
        if (s + 2 < 8) {
#pragma unroll
            for (int i = 0; i < 8; ++i) { const int rho = kq + 4 * i; const unsigned vi = list[(2 * (s + 2) + ((rho >> 2) & 1)) * 16 + 4 * (rho >> 3) + (rho & 3)]; vn[s & 1][i] = *(const u32x4*)(vbase + (size_t)vi * NPROJ); }
        }
        s16x4 lo[8], hi[8];
#pragma unroll
        for (int dt = 0; dt < 8; ++dt) {
            const int a1 = vtb + voff(8 * kq + q4, 2 * dt + (p4 >> 1)) + 8 * (p4 & 1), a2 = vtb + voff(8 * kq + 4 + q4, 2 * dt + (p4 >> 1)) + 8 * (p4 & 1);
            asm volatile("ds_read_b64_tr_b16 %0, %1" : "=&v"(lo[dt]) : "v"(a1) : "memory");
            asm volatile("ds_read_b64_tr_b16 %0, %1" : "=&v"(hi[dt]) : "v"(a2) : "memory"); }
        asm volatile("s_waitcnt lgkmcnt(0)" ::: "memory"); __builtin_amdgcn_sched_barrier(0);
#pragma unroll
        for (int dt = 0; dt < 8; ++dt)
            o[dt] = __builtin_amdgcn_mfma_f32_16x16x32_bf16((bf16x8){lo[dt][0], lo[dt][1], lo[dt][2], lo[dt][3], hi[dt][0], hi[dt][1], hi[dt][2], hi[dt][3]}, pf[s], o[dt], 0, 0, 0);
    }
    const float rl = 1.f / sum;
    if (c16 < 12) { bf16* op = MIX + (rowb + t) * D + 2560 + c16 * 128 + 4 * kq;
#pragma unroll
        for (int dt = 0; dt < 8; ++dt) { u32x2 w; w.x = cvtpk(o[dt][0] * rl, o[dt][1] * rl); w.y = cvtpk(o[dt][2] * rl, o[dt][3] * rl); *(u32x2*)(op + 16 * dt) = w; } }
    asm volatile("s_waitcnt lgkmcnt(0)" ::: "memory");
}
}
__device__ __forceinline__ void dsa_gather_phase(Frame& F, int qbase) {
    volatile LAS unsigned* qs = (volatile LAS unsigned*)(F.lds + LDSCTL_OFF + 64);
    const bf16* PROJ = (const bf16*)(ws_base() + WS_PROJ); const u64* MASK = (const u64*)(ws_base() + WS_MASK); bf16* MIX = (bf16*)(ws_base() + WS_MIX);
    LAS float* t5l = (LAS float*)(F.lds + dg::T5_OFF);
    for (int i = F.tid; i < 12 * 192; i += 512) t5l[i] = ((const float*)(ws_base() + WS_T5))[i];
    int x = (int)((unsigned)__builtin_amdgcn_s_getreg((3 << 11) | 20) & 7u), tries = 0;
    while (tries < 8) {
        if (F.tid == 0) qs[0] = __hip_atomic_fetch_add(ctl_base() + CW_Q + 64 * (qbase + x), 1u, RLX_AGENT);
        __syncthreads();
        const unsigned idx = qs[0];
        __syncthreads();
        if (idx >= 256u) { x = (x + 1) & 7; ++tries; continue; }
        const int b = x >> 1, t = ((x & 1) * 256 + (int)idx) * 8 + F.wave;
        dg::query(PROJ, MASK, MIX, b, t, F.lds + F.wave * dg::WLDS, t5l, F.lane);
    }
}
struct KArgs { const float* in[26]; float* out; unsigned char* ws; };
static_assert(sizeof(KArgs) == 224, "kernarg layout");
constexpr int NWAVES = 8;
#ifndef PHASE_MASK
#define PHASE_MASK 0xFFFF
#endif
#ifndef PROBE_MASK
#define PROBE_MASK 0
#endif
#ifndef PROBE_MULT
#define PROBE_MULT 4
#endif
__global__ void __launch_bounds__(NWAVES * 64, 2) trunk_fwd(KArgs args) {
    extern __shared__ __attribute__((aligned(16))) unsigned char lds_raw[];
    Frame F;
    F.lds = (LAS unsigned char*)lds_raw;
#define RELAUNDER() do { int t_ = threadIdx.x; asm volatile("" : "+v"(t_)); F.tid = t_; F.lane = t_ & 63; F.wave = __builtin_amdgcn_readfirstlane(t_ >> 6); } while (0)
    RELAUNDER();
    F.G = gridDim.x; { const int bx = blockIdx.x; F.vcu = (F.G % 8 == 0) ? (bx % 8) * (F.G / 8) + bx / 8 : bx; }
    for (int u = F.tid; u < (LDS_BYTES - LDSCTL_OFF) / 4; u += NWAVES * 64) ((LAS unsigned*)(F.lds + LDSCTL_OFF))[u] = 0u;
    __syncthreads();
    (void)xcd_barrier_post(ctl_base() + CW_BAR, (volatile LAS unsigned*)(F.lds + LDSCTL_OFF));
#define GRID_BAR() do { XcdBarrier b_; b_.bar = ctl_base() + CW_BAR; b_.x = xb_xcc_id(); b_.st = (volatile LAS unsigned*)(F.lds + LDSCTL_OFF); xcd_barrier(b_); } while (0)
    unsigned char* ws = ws_base();
    unsigned long long pr_last = 0ull, pr_acc = 0ull;
    if (PROBE_MASK) pr_last = __builtin_amdgcn_s_memrealtime();
#define PSTAMP(id) do { if (PROBE_MASK) { const unsigned long long n_ = __builtin_amdgcn_s_memrealtime(); if ((PROBE_MASK >> (id)) & 1) pr_acc += n_ - pr_last; pr_last = n_; } } while (0)
    bf16* HB = (bf16*)(ws + WS_HB); bf16* PROJ = (bf16*)(ws + WS_PROJ); bf16* QA = (bf16*)(ws + WS_QA); bf16* KVb = (bf16*)(ws + WS_KV);
    bf16* Gb = (bf16*)(ws + WS_G); bf16* MIX = (bf16*)(ws + WS_MIX); bf16* FFH = (bf16*)(ws + WS_FFH); float* SS = (float*)(ws + WS_SS);
    const float* cosA = (const float*)(ws + WS_COSA); const float* sinA = (const float*)(ws + WS_SINA); const float* cosI = (const float*)(ws + WS_COSI); const float* sinI = (const float*)(ws + WS_SINI);

    p0_prologue(F);
    GRID_BAR();
    PSTAMP(0);
#pragma unroll 1
    for (int l = 0; l < DEPTH; ++l) {
        unsigned char* wl = ws + WS_W0 + (size_t)l * W_LSTRIDE;
        { pg8::Gemm g{HB, (const bf16*)(wl + W_IN), M, NPROJ, D, D}; pg8::StaticOrder S; S.init(M, NPROJ, F.G, (int)blockIdx.x);
          pg8::EpiProj E{PROJ, SS, cosA, sinA, cosI, sinI};
          pg8::gemm_phase<pg8::EpiProj, pg8::StaticOrder, true, true>(F.lds, g, S, E); }
        GRID_BAR();
        PSTAMP(1);
        if (PHASE_MASK & 1) {
          { pg8::Gemm g{PROJ + C_QLAT, (const bf16*)(wl + W_UQ), M, NQA, 768, NPROJ}; pg8::StaticOrder S; S.init(M, NQA, F.G, (int)blockIdx.x);
            pg8::EpiUp<true> E{QA, SS, cosA, sinA};
            pg8::gemm_phase<pg8::EpiUp<true>, pg8::StaticOrder, true, true>(F.lds, g, S, E); }
          { pg8::Gemm g{PROJ + C_KVLAT, (const bf16*)(wl + W_UKV), M, NKV, 512, NPROJ}; pg8::StaticOrder S; S.init(M, NKV, F.G, (int)blockIdx.x);
            pg8::EpiUp<false> E{KVb, SS, cosA, sinA};
            pg8::gemm_phase<pg8::EpiUp<false>, pg8::StaticOrder, true, true>(F.lds, g, S, E); }
        }
        PSTAMP(10); RELAUNDER(); if (PHASE_MASK & 2) s5_phase<false>(F, l);
        PSTAMP(11); RELAUNDER(); if (PHASE_MASK & 4) dsa_index_phase<((PROBE_MASK >> 20) & 1) != 0>(F, l * 32 + 0, pr_acc);
        GRID_BAR();
        PSTAMP(2);
        RELAUNDER(); if (PHASE_MASK & 2) s5_phase<true>(F, l);
        PSTAMP(13); RELAUNDER(); if (PHASE_MASK & 1) attn_phase(F, l * 32 + 8);
        GRID_BAR();
        PSTAMP(3);
        if (PHASE_MASK & 2) {
          pg8::Gemm g{Gb, (const bf16*)(wl + W_GLU), M, 1024, 1024, 1024}; pg8::StaticOrder S; S.init(M, 1024, F.G, (int)blockIdx.x);
          pg8::EpiGlu E{MIX, Gb, inp(I_BGLU) + l * 1024};
          pg8::gemm_phase<pg8::EpiGlu, pg8::StaticOrder, true, true>(F.lds, g, S, E); }
        PSTAMP(15); RELAUNDER(); if (PHASE_MASK & 4) dsa_gather_phase(F, l * 32 + 16);
        GRID_BAR();
        PSTAMP(4);
        { pg8::Gemm g{MIX, (const bf16*)(wl + W_OUT), M, D, D, D}; pg8::StaticOrder S; S.init(M, D, F.G, (int)blockIdx.x);
          pg8::EpiRes E{HB};
          pg8::gemm_phase<pg8::EpiRes, pg8::StaticOrder, true, true>(F.lds, g, S, E); }
        GRID_BAR();
        PSTAMP(5);
        RELAUNDER(); ln_phase<false, false>(F, nullptr, inp(I_LN1G) + l * D, inp(I_LN1B) + l * D);
        GRID_BAR();
        PSTAMP(6);
        { pg8::Gemm g{HB, (const bf16*)(wl + W_1), M, DFF, D, D}; pg8::StaticOrder S; S.init(M, DFF, F.G, (int)blockIdx.x);
          pg8::EpiRelu2 E{FFH};
          pg8::gemm_phase<pg8::EpiRelu2, pg8::StaticOrder, true, true>(F.lds, g, S, E); }
        GRID_BAR();
        PSTAMP(7);
        { pg8::Gemm g{FFH, (const bf16*)(wl + W_2), M, D, DFF, DFF}; pg8::StaticOrder S; S.init(M, D, F.G, (int)blockIdx.x);
          pg8::EpiRes E{HB};
          pg8::gemm_phase<pg8::EpiRes, pg8::StaticOrder, true, true>(F.lds, g, S, E); }
        GRID_BAR();
        PSTAMP(8);
        RELAUNDER(); if (l + 1 < DEPTH) ln_phase<false, false>(F, nullptr, inp(I_LN2G) + l * D, inp(I_LN2B) + l * D); else ln_phase<false, true>(F, nullptr, inp(I_LN2G) + l * D, inp(I_LN2B) + l * D);
        if (l + 1 < DEPTH) GRID_BAR();
        PSTAMP(9);
    }
    if (PROBE_MASK) { if (blockIdx.x == 0 && threadIdx.x == 0) { const unsigned long long t0_ = __builtin_amdgcn_s_memrealtime(), w_ = pr_acc * PROBE_MULT; while (__builtin_amdgcn_s_memrealtime() - t0_ < w_) __builtin_amdgcn_s_sleep(8); } }
}

extern "C" void kernel_launch(void* const* d_in, const int* in_sizes, int n_in, void* d_out, int out_size, void* d_ws, size_t ws_size, hipStream_t stream) {
    static int grid = 0;
    if (grid == 0) {
        if (n_in != 26 || in_sizes[0] != M * D || out_size != M * D || ws_size < WS_END) { fprintf(stderr, "kernel_launch: unexpected shapes (n_in %d, out %d, ws %zu)\n", n_in, out_size, ws_size); grid = -1; return; }
        int dev = 0, cus = 0;
        if (hipGetDevice(&dev) != hipSuccess || hipDeviceGetAttribute(&cus, hipDeviceAttributeMultiprocessorCount, dev) != hipSuccess) { grid = -1; return; }
        if (hipFuncSetAttribute((const void*)trunk_fwd, hipFuncAttributeMaxDynamicSharedMemorySize, LDS_BYTES) != hipSuccess) { fprintf(stderr, "kernel_launch: hipFuncSetAttribute failed\n"); grid = -1; return; }
        int per_cu = 0;
        if (hipOccupancyMaxActiveBlocksPerMultiprocessor(&per_cu, (const void*)trunk_fwd, NWAVES * 64, LDS_BYTES) != hipSuccess || per_cu < 1) { fprintf(stderr, "kernel_launch: occupancy query says %d\n", per_cu); }
        (void)hipGetLastError();
        grid = cus;
    }
    if (grid < 0) return;
    if (hipMemsetAsync((char*)d_ws + WS_CTL, 0, CTL_BYTES, stream) != hipSuccess) return;
    KArgs a{};
    for (int i = 0; i < 26; ++i) a.in[i] = (const float*)d_in[i];
    a.out = (float*)d_out; a.ws = (unsigned char*)d_ws;
    hipLaunchKernelGGL(trunk_fwd, dim3(grid), dim3(NWAVES * 64), LDS_BYTES, stream, a);
}
```
